# Optimizing an MI355X kernel written in HIP

```python
import jax, jax.numpy as jnp
from jax import lax
import numpy as np

D_MODEL = 1024
BATCH = 8
SEQ = 8192
DEPTH = 1

HEAD_DIM = 64
ATTN_WIDTH = D_MODEL // 2
N_Q_HEADS = ATTN_WIDTH // HEAD_DIM
N_KV_HEADS = max(1, N_Q_HEADS // 4)
Q_PER_KV = N_Q_HEADS // N_KV_HEADS
KV_WIDTH = N_KV_HEADS * HEAD_DIM
WINDOW = 128
BLOCK = 128
GMLP_WIDTH = D_MODEL - ATTN_WIDTH
GMLP_GROUPS = GMLP_WIDTH // HEAD_DIM
GMLP_GROUP_DIM = GMLP_WIDTH // GMLP_GROUPS
CHUNK = 128
MIX_WIDTH = ATTN_WIDTH + GMLP_WIDTH
D_FF = 4 * D_MODEL
IN_WIDTH = ATTN_WIDTH + 2 * KV_WIDTH + 2 * GMLP_WIDTH
SPLITS = [ATTN_WIDTH, ATTN_WIDTH + KV_WIDTH, ATTN_WIDTH + 2 * KV_WIDTH,
          ATTN_WIDTH + 2 * KV_WIDTH + GMLP_WIDTH]
ALPHA = (2.0 * DEPTH) ** 0.25
BETA = (8.0 * DEPTH) ** -0.25
LN_EPS = 1e-5
NEG_INF = -1e30

kernel_name = "hybrid_swa_sgu_deepnorm_block"


def layer_norm(x, g, b):
    xf = x.astype(jnp.float32)
    mu = jnp.mean(xf, axis=-1, keepdims=True)
    var = jnp.mean(jnp.square(xf - mu), axis=-1, keepdims=True)
    return ((xf - mu) * lax.rsqrt(var + LN_EPS) * g.astype(jnp.float32)
            + b.astype(jnp.float32)).astype(x.dtype)


def rms_norm(x, g):
    xf = x.astype(jnp.float32)
    ms = jnp.mean(jnp.square(xf), axis=-1, keepdims=True)
    return (xf * lax.rsqrt(ms + LN_EPS) * g.astype(jnp.float32)).astype(x.dtype)


def alibi_slopes():
    i = jnp.arange(1, N_Q_HEADS + 1, dtype=jnp.float32)
    return jnp.exp2(-8.0 * i / N_Q_HEADS)


def banded_window_attention(q, k, v, sink):
    B, S = q.shape[0], q.shape[1]
    nb = S // BLOCK
    qb = q.reshape(B, nb, BLOCK, N_KV_HEADS, Q_PER_KV, HEAD_DIM)
    pad = ((0, 0), (BLOCK, BLOCK), (0, 0))
    kp = jnp.pad(k, pad).reshape(B, nb + 2, BLOCK, N_KV_HEADS, HEAD_DIM)
    vp = jnp.pad(v, pad).reshape(B, nb + 2, BLOCK, N_KV_HEADS, HEAD_DIM)
    kb = jnp.concatenate([kp[:, :-2], kp[:, 1:-1], kp[:, 2:]], axis=2)
    vb = jnp.concatenate([vp[:, :-2], vp[:, 1:-1], vp[:, 2:]], axis=2)
    s = jnp.einsum('bnqgrd,bnkgd->bngrqk', qb, kb,
                   preferred_element_type=jnp.float32) * (HEAD_DIM ** -0.5)
    blk = jnp.arange(nb, dtype=jnp.int32)[:, None] * BLOCK
    q_pos = blk + jnp.arange(BLOCK, dtype=jnp.int32)[None, :]
    k_pos = blk - BLOCK + jnp.arange(3 * BLOCK, dtype=jnp.int32)[None, :]
    dist = jnp.abs(q_pos[:, :, None] - k_pos[:, None, :])
    valid = (dist <= WINDOW) & (k_pos[:, None, :] >= 0) & (k_pos[:, None, :] < S)
    slopes = alibi_slopes().reshape(N_KV_HEADS, Q_PER_KV)
    bias = -slopes[None, :, :, None, None] * dist[:, None, None].astype(jnp.float32)
    s = jnp.where(valid[:, None, None], s + bias, NEG_INF)
    sink_b = sink.astype(jnp.float32).reshape(1, 1, N_KV_HEADS, Q_PER_KV, 1, 1)
    m = jnp.maximum(jnp.max(s, axis=-1, keepdims=True), sink_b)
    e = jnp.exp(s - m)
    p = e / (jnp.sum(e, axis=-1, keepdims=True) + jnp.exp(sink_b - m))
    o = jnp.einsum('bngrqk,bnkgd->bnqgrd', p.astype(vb.dtype), vb)
    return o.reshape(B, S, ATTN_WIDTH)


def chunked_spatial_gating(u, vg, ln_g, ln_b, w_s, b_s):
    B, S = u.shape[0], u.shape[1]
    nc = S // CHUNK
    vn = layer_norm(vg, ln_g, ln_b).reshape(B, nc, CHUNK, GMLP_GROUPS, GMLP_GROUP_DIM)
    mixed = jnp.einsum('gts,bnsgc->bntgc', w_s, vn) + b_s.T[None, None, :, :, None]
    return u * mixed.reshape(B, S, GMLP_WIDTH)


def setup_inputs(seed: int = 0) -> dict:
    key = jax.random.key(seed)
    ks = jax.random.split(key, 16)
    f32 = jnp.float32
    L = DEPTH
    x = jax.random.normal(ks[0], (BATCH, SEQ, D_MODEL), f32)
    w_in = jax.random.normal(ks[1], (L, D_MODEL, IN_WIDTH), f32) * D_MODEL ** -0.5
    w_in = w_in.at[:, :, SPLITS[1]:SPLITS[2]].multiply(BETA)
    sink = 0.5 * jax.random.normal(ks[2], (L, N_Q_HEADS), f32)
    gmlp_ln_g = 1.0 + 0.05 * jax.random.normal(ks[3], (L, GMLP_WIDTH), f32)
    gmlp_ln_b = 0.02 * jax.random.normal(ks[4], (L, GMLP_WIDTH), f32)
    w_spatial = jax.random.normal(ks[5], (L, GMLP_GROUPS, CHUNK, CHUNK), f32) * CHUNK ** -0.5
    b_spatial = 1.0 + 0.1 * jax.random.normal(ks[6], (L, GMLP_GROUPS, CHUNK), f32)
    attn_norm_g = 1.0 + 0.05 * jax.random.normal(ks[7], (L, ATTN_WIDTH), f32)
    gmlp_norm_g = 1.0 + 0.05 * jax.random.normal(ks[8], (L, GMLP_WIDTH), f32)
    w_out = jax.random.normal(ks[9], (L, MIX_WIDTH, D_MODEL), f32) * (MIX_WIDTH ** -0.5 * BETA)
    ln1_g = 1.0 + 0.05 * jax.random.normal(ks[10], (L, D_MODEL), f32)
    ln1_b = 0.02 * jax.random.normal(ks[11], (L, D_MODEL), f32)
    w_ff1 = jax.random.normal(ks[12], (L, D_MODEL, D_FF), f32) * (D_MODEL ** -0.5 * BETA)
    w_ff2 = jax.random.normal(ks[13], (L, D_FF, D_MODEL), f32) * (D_FF ** -0.5 * BETA)
    ln2_g = 1.0 + 0.05 * jax.random.normal(ks[14], (L, D_MODEL), f32)
    ln2_b = 0.02 * jax.random.normal(ks[15], (L, D_MODEL), f32)
    return {"x": x, "w_in": w_in, "sink": sink, "gmlp_ln_g": gmlp_ln_g,
            "gmlp_ln_b": gmlp_ln_b, "w_spatial": w_spatial, "b_spatial": b_spatial,
            "attn_norm_g": attn_norm_g, "gmlp_norm_g": gmlp_norm_g, "w_out": w_out,
            "ln1_g": ln1_g, "ln1_b": ln1_b, "w_ff1": w_ff1, "w_ff2": w_ff2,
            "ln2_g": ln2_g, "ln2_b": ln2_b}


def reference(x, w_in, sink, gmlp_ln_g, gmlp_ln_b, w_spatial, b_spatial,
              attn_norm_g, gmlp_norm_g, w_out, ln1_g, ln1_b, w_ff1, w_ff2,
              ln2_g, ln2_b):
    for l in range(DEPTH):
        proj = jnp.einsum('bsd,de->bse', x, w_in[l])
        q, k, v, gu, gv = jnp.split(proj, SPLITS, axis=-1)
        attn = banded_window_attention(q, k, v, sink[l])
        gu = jax.nn.gelu(gu, approximate=False)
        gv = jax.nn.gelu(gv, approximate=False)
        sgu = chunked_spatial_gating(gu, gv, gmlp_ln_g[l], gmlp_ln_b[l],
                                     w_spatial[l], b_spatial[l])
        mixed = jnp.concatenate([rms_norm(attn, attn_norm_g[l]),
                                 rms_norm(sgu, gmlp_norm_g[l])], axis=-1)
        mix_out = jnp.einsum('bse,ed->bsd', mixed, w_out[l])
        x = layer_norm(ALPHA * x + mix_out, ln1_g[l], ln1_b[l])
        h = jnp.square(jax.nn.relu(jnp.einsum('bsd,df->bsf', x, w_ff1[l])))
        ff_out = jnp.einsum('bsf,fd->bsd', h, w_ff2[l])
        x = layer_norm(ALPHA * x + ff_out, ln2_g[l], ln2_b[l])
    return x
```

```cpp
#include <hip/hip_runtime.h>
#include <hip/hip_cooperative_groups.h>
#include <cstdio>
#include <cstdint>
namespace cg = cooperative_groups;
#define MK_N_LAUNCHES 1
namespace pg8 {
#define PG8_LAS __attribute__((address_space(3)))
typedef unsigned short bf16_t;
typedef short bf16x8 __attribute__((ext_vector_type(8)));
typedef float f32x4 __attribute__((ext_vector_type(4)));
typedef unsigned u32x4 __attribute__((ext_vector_type(4)));
constexpr int BM = 256, BK = 64, HALF = 128, HTB = HALF * BK * 2  , STAGE_BYTES = 8 * HTB, NXCD = 8, WGM = 8;

__host__ __device__ __forceinline__ int lds_byte(int r, int c) { const int st = (r >> 4) * 2 + (c >> 5), rr = r & 15, cc = c & 31, ob = rr * 64 + cc * 2; return st * 1024 + (ob ^ (((ob >> 9) & 1) << 5)); }
__host__ __device__ __forceinline__ void stage_rc(int b, int& R, int& C) { const int st = b / 1024, sb = b % 1024, swz = sb ^ (((sb >> 9) & 1) << 5); R = (st >> 1) * 16 + swz / 64; C = (st & 1) * 32 + (swz % 64) / 2; }
__host__ __device__ __forceinline__ int perm32(int rho) { const int n = rho >> 4, i = rho & 15; return 8 * (i >> 2) + 4 * n + (i & 3); }

struct Unit { int pm, pn; };
struct Gemm { const bf16_t* A; const bf16_t* Bt; int M, N, K; };

struct StaticOrder {
    int nM, nN, nwg, G, c;
    __host__ __device__ void init(int M, int N, int G_, int c_) { nM = M / BM; nN = N / BM; nwg = nM * nN; G = G_; c = c_; }
    __host__ __device__ bool next(int i, Unit& u) const {
        const long L = (long)i * G + c; if (L >= nwg) return false;
        int wgid = (int)L; { const int q = nwg / NXCD, r = nwg % NXCD, xcd = wgid % NXCD, off = wgid / NXCD; wgid = (xcd < r ? xcd * (q + 1) : r * (q + 1) + (xcd - r) * q) + off; }
        const int nig = WGM * nN, gid = wgid / nig, fm = gid * WGM, gsz = (nM - fm) < WGM ? (nM - fm) : WGM;
        u.pm = fm + ((wgid % nig) % gsz); u.pn = (wgid % nig) / gsz; return true;
    }
    __device__ __forceinline__ void a_ready(const Unit&) const {}
    __device__ __forceinline__ void done(const Unit&) const {}
};

__device__ __forceinline__ unsigned cvt_pk_bf16(float lo, float hi) { unsigned r; asm volatile("v_cvt_pk_bf16_f32 %0, %1, %2" : "=v"(r) : "v"(lo), "v"(hi)); return r; }
typedef float f32x2 __attribute__((ext_vector_type(2)));
__device__ __forceinline__ f32x2 gelu_pk(f32x2 v) {
    const f32x2 av = __builtin_elementwise_abs(v), d = av * 0.2316418882f + 1.0f;
    f32x2 t; t.x = __builtin_amdgcn_rcpf(d.x); t.y = __builtin_amdgcn_rcpf(d.y);
    f32x2 q = t * 0.5307027145f + (-0.7265760135f); q = q * t + 0.7107068705f; q = q * t + (-0.142248368f); q = q * t + 0.127414796f; q = q * t;
    const f32x2 s = (v * v) * (-0.72134752044f);
    f32x2 e; e.x = __builtin_amdgcn_exp2f(s.x); e.y = __builtin_amdgcn_exp2f(s.y);
    const f32x2 m = v * (q * e), r = v - m;
    f32x2 o; o.x = v.x < 0.f ? m.x : r.x; o.y = v.y < 0.f ? m.y : r.y; return o;
}
typedef unsigned u32x2 __attribute__((ext_vector_type(2)));
typedef __bf16 bf16x2_t __attribute__((ext_vector_type(2)));
__device__ __forceinline__ unsigned cvtpk(float lo, float hi) { f32x2 v = {lo, hi}; bf16x2_t b = __builtin_convertvector(v, bf16x2_t); return __builtin_bit_cast(unsigned, b); }
struct EpiAct {
    static constexpr bool PERM = true, AFTER_DRAIN = false;
    bf16_t* O; int ldc; int mode; float q_scale;
    __device__ __forceinline__ void operator()(const f32x4 (&acc)[2][2][4][2], const Unit& u, int wr, int wc, int fr, int fq) const {
        const int row0 = u.pm * BM + wr * 64 + fr; const int col0 = u.pn * BM + wc * 32 + 8 * fq;
        int act = 2; float sc = 1.f;
        if (mode == 0) { act = (u.pn >= 3) ? 1 : 0; sc = (u.pn < 2) ? q_scale : 1.f; }
#pragma unroll
        for (int ai = 0; ai < 2; ++ai)
#pragma unroll
            for (int m = 0; m < 4; ++m) { bf16_t* rowp = O + (size_t)(row0 + ai * HALF + m * 16) * ldc + col0;
#pragma unroll
                for (int bj = 0; bj < 2; ++bj) { f32x4 v0 = acc[ai][bj][m][0], v1 = acc[ai][bj][m][1];
                    if (act == 1) { f32x2 a = gelu_pk((f32x2){v0[0], v0[1]}), b = gelu_pk((f32x2){v0[2], v0[3]}), c = gelu_pk((f32x2){v1[0], v1[1]}), d = gelu_pk((f32x2){v1[2], v1[3]});
                        v0 = (f32x4){a.x, a.y, b.x, b.y}; v1 = (f32x4){c.x, c.y, d.x, d.y}; }
                    else if (act == 2) {
#pragma unroll
                        for (int k = 0; k < 4; ++k) { const float a = fmaxf(v0[k], 0.f), b = fmaxf(v1[k], 0.f); v0[k] = a * a; v1[k] = b * b; } }
                    else { v0 = v0 * sc; v1 = v1 * sc; }
                    u32x4 w; w.x = cvtpk(v0[0], v0[1]); w.y = cvtpk(v0[2], v0[3]); w.z = cvtpk(v1[0], v1[1]); w.w = cvtpk(v1[2], v1[3]);
                    *(u32x4*)(rowp + bj * HALF) = w; } }
    }
};
struct EpiRes {
    static constexpr bool PERM = false, AFTER_DRAIN = false;
    const float* basef; const bf16_t* baseh; float* out; int ldc; float alpha;
    __device__ __forceinline__ void operator()(const f32x4 (&acc)[2][2][4][2], const Unit& u, int wr, int wc, int fr, int fq) const {
        const int row0 = u.pm * BM + wr * 64 + fr; const int col0 = u.pn * BM + wc * 32 + 4 * fq;
#pragma unroll
        for (int ai = 0; ai < 2; ++ai)
#pragma unroll
            for (int m = 0; m < 4; ++m) { const size_t off = (size_t)(row0 + ai * HALF + m * 16) * ldc + col0;
#pragma unroll
                for (int bj = 0; bj < 2; ++bj)
#pragma unroll
                    for (int n = 0; n < 2; ++n) { const size_t c = off + bj * HALF + n * 16; f32x4 bs;
                        if (basef) bs = *(const f32x4*)(basef + c);
                        else { const u32x2 w = *(const u32x2*)(baseh + c); bs = (f32x4){__uint_as_float(w.x << 16), __uint_as_float(w.x & 0xffff0000u), __uint_as_float(w.y << 16), __uint_as_float(w.y & 0xffff0000u)}; }
                        *(f32x4*)(out + c) = bs * alpha + acc[ai][bj][m][n]; }
                asm volatile("" ::: "memory"); }
    }
};
template <class Epi, class Sched, bool ALIGN_EPI = false, bool SP2 = false>
__device__ __forceinline__ void gemm_phase(PG8_LAS unsigned char* lds, const Gemm g, const Sched& S, const Epi& E) {
    const int tid = threadIdx.x, wid = __builtin_amdgcn_readfirstlane(tid >> 6), lane = tid & 63, wr = wid >> 2, wc = wid & 3, fr = lane & 15, fq = lane >> 4;
    const int K = g.K, nt = K / BK;
    unsigned voffA[2], voffB[2];
#pragma unroll
    for (int i = 0; i < 2; ++i) { int R, C; stage_rc(tid * 16 + i * 8192, R, C); const int Rb = Epi::PERM ? ((R & ~31) + perm32(R & 31)) : R;
        voffA[i] = (unsigned)(R * K + C) * 2u; voffB[i] = (unsigned)(Rb * K + C) * 2u; }
    const size_t kstep = (size_t)(BK * 2);
    const size_t hstep = (size_t)HALF * K * 2;
    const size_t tstep = 2 * hstep;
    const unsigned ldsw = (unsigned)wid * 1024u;
    const int aoff = lds_byte(wr * 64 + fr, fq * 8), boff = lds_byte(wc * 32 + fr, fq * 8);
#define PG8_SA(b, h) (((b) * 2 + (h)) * HTB)
#define PG8_SB(b, h) ((4 + (b) * 2 + (h)) * HTB)
#define PG8_STAGE(bufoff, gbase, voff) do { _Pragma("unroll") for (int _i = 0; _i < 2; ++_i) \
        __builtin_amdgcn_global_load_lds((const unsigned*)((const char*)(gbase) + (voff)[_i]), (PG8_LAS unsigned*)(lds + (bufoff) + ldsw + _i * 8192), 16, 0, 0); } while (0)
#define PG8_LDA(dst, b, h) do { _Pragma("unroll") for (int m = 0; m < 4; ++m) _Pragma("unroll") for (int k = 0; k < 2; ++k) dst[m][k] = *(const PG8_LAS bf16x8*)(lds + PG8_SA(b, h) + aoff + m * 2048 + k * 1024); } while (0)
#define PG8_LDB(dst, b, h) do { _Pragma("unroll") for (int n = 0; n < 2; ++n) _Pragma("unroll") for (int k = 0; k < 2; ++k) dst[n][k] = *(const PG8_LAS bf16x8*)(lds + PG8_SB(b, h) + boff + n * 2048 + k * 1024); } while (0)
#define PG8_MMA(ai, bj, At, Bt) do { __builtin_amdgcn_s_setprio(1); _Pragma("unroll") for (int m = 0; m < 4; ++m) _Pragma("unroll") for (int n = 0; n < 2; ++n) _Pragma("unroll") for (int k = 0; k < 2; ++k) \
        acc[ai][bj][m][n] = __builtin_amdgcn_mfma_f32_16x16x32_bf16(Bt[n][k], At[m][k], acc[ai][bj][m][n], 0, 0, 0); __builtin_amdgcn_s_setprio(0); } while (0)
#define PG8_WAIT_V(n) asm volatile("s_waitcnt vmcnt(" #n ")" ::: "memory")
#define PG8_WAIT_L(n) asm volatile("s_waitcnt lgkmcnt(" #n ")" ::: "memory")
#define PG8_BAR __builtin_amdgcn_s_barrier()
#define PG8_SCHED __builtin_amdgcn_sched_barrier(0)
    Unit cur, nxt; int ui = 0;
    if (!S.next(0, cur)) return;
    f32x4 acc[2][2][4][2];
#pragma unroll
    for (int a = 0; a < 2; ++a)
#pragma unroll
        for (int b = 0; b < 2; ++b)
#pragma unroll
            for (int m = 0; m < 4; ++m)
#pragma unroll
                for (int n = 0; n < 2; ++n) acc[a][b][m][n] = (f32x4){0.f, 0.f, 0.f, 0.f};
    bf16x8 At[4][2], B0[2][2], B1[2][2];
    const char* cA = (const char*)g.A + (size_t)cur.pm * tstep; const char* cB = (const char*)g.Bt + (size_t)cur.pn * tstep;
    S.a_ready(cur);
    if constexpr (SP2) {
        PG8_STAGE(PG8_SB(0, 0), cB, voffB); PG8_STAGE(PG8_SB(0, 1), cB + hstep, voffB); PG8_STAGE(PG8_SA(0, 0), cA, voffA); PG8_STAGE(PG8_SA(0, 1), cA + hstep, voffA);
        if (wr == 1) PG8_BAR;
        PG8_WAIT_V(2); PG8_BAR;
        PG8_STAGE(PG8_SB(1, 0), cB + kstep, voffB); PG8_STAGE(PG8_SA(1, 0), cA + kstep, voffA); PG8_STAGE(PG8_SB(1, 1), cB + hstep + kstep, voffB);
        PG8_WAIT_V(6); PG8_BAR;
    } else {
        PG8_STAGE(PG8_SB(0, 0), cB, voffB); PG8_STAGE(PG8_SA(0, 0), cA, voffA); PG8_STAGE(PG8_SB(0, 1), cB + hstep, voffB); PG8_STAGE(PG8_SA(0, 1), cA + hstep, voffA);
        if (wr == 1) PG8_BAR;
        PG8_WAIT_V(4); PG8_BAR;
        PG8_STAGE(PG8_SB(1, 0), cB + kstep, voffB); PG8_STAGE(PG8_SA(1, 0), cA + kstep, voffA); PG8_STAGE(PG8_SB(1, 1), cB + hstep + kstep, voffB);
        PG8_WAIT_V(6); PG8_BAR;
    }
    for (;;) {
        const bool has_next = S.next(ui + 1, nxt);
        const char* nA = has_next ? (const char*)g.A + (size_t)nxt.pm * tstep : cA; const char* nB = has_next ? (const char*)g.Bt + (size_t)nxt.pn * tstep : cB;
        for (int t = 0; t < nt; t += 2) {
            const bool last = (t == nt - 2);
            const char* a1 = cA + (size_t)(t + 1) * kstep;
            const char* a2 = last ? nA : cA + (size_t)(t + 2) * kstep; const char* b2 = last ? nB : cB + (size_t)(t + 2) * kstep;
            const char* a3 = a2 + kstep; const char* b3 = b2 + kstep;
            if (last && has_next) S.a_ready(nxt);
            if constexpr (SP2) {
            PG8_LDB(B0, 0, 0); PG8_LDB(B1, 0, 1); PG8_SCHED; PG8_LDA(At, 0, 0); PG8_STAGE(PG8_SA(1, 1), a1 + hstep, voffA);
            PG8_WAIT_V(8); PG8_WAIT_L(0); PG8_BAR; PG8_MMA(0, 0, At, B0); PG8_MMA(0, 1, At, B1); PG8_BAR; PG8_SCHED;
            PG8_LDA(At, 0, 1); PG8_STAGE(PG8_SB(0, 0), b2, voffB); PG8_STAGE(PG8_SB(0, 1), b2 + hstep, voffB); PG8_STAGE(PG8_SA(0, 0), a2, voffA);
            PG8_WAIT_V(8); PG8_WAIT_L(0); PG8_BAR; PG8_MMA(1, 0, At, B0); PG8_MMA(1, 1, At, B1); PG8_BAR; PG8_SCHED;
            PG8_LDB(B0, 1, 0); PG8_LDB(B1, 1, 1); PG8_SCHED; PG8_LDA(At, 1, 0); PG8_STAGE(PG8_SA(0, 1), a2 + hstep, voffA);
            PG8_WAIT_V(8); PG8_WAIT_L(0); PG8_BAR; PG8_MMA(0, 0, At, B0); PG8_MMA(0, 1, At, B1); PG8_BAR; PG8_SCHED;
            PG8_LDA(At, 1, 1); PG8_STAGE(PG8_SB(1, 0), b3, voffB); PG8_STAGE(PG8_SB(1, 1), b3 + hstep, voffB); PG8_STAGE(PG8_SA(1, 0), a3, voffA);
            PG8_WAIT_V(8); PG8_WAIT_L(0); PG8_BAR; PG8_MMA(1, 0, At, B0); PG8_MMA(1, 1, At, B1); PG8_BAR; PG8_SCHED;
            } else {
            PG8_LDB(B0, 0, 0); PG8_SCHED; PG8_LDA(At, 0, 0); PG8_STAGE(PG8_SA(1, 1), a1 + hstep, voffA);
            PG8_WAIT_L(8); PG8_BAR; PG8_WAIT_L(0); PG8_MMA(0, 0, At, B0); PG8_BAR; PG8_SCHED;
            PG8_LDB(B1, 0, 1); PG8_STAGE(PG8_SB(0, 0), b2, voffB);
            PG8_BAR; PG8_WAIT_L(0); PG8_MMA(0, 1, At, B1); PG8_BAR;
            PG8_LDA(At, 0, 1); PG8_STAGE(PG8_SA(0, 0), a2, voffA);
            PG8_BAR; PG8_WAIT_L(0); PG8_MMA(1, 0, At, B0); PG8_BAR; PG8_SCHED;
            PG8_STAGE(PG8_SB(0, 1), b2 + hstep, voffB);
            PG8_WAIT_V(6); PG8_BAR; PG8_MMA(1, 1, At, B1); PG8_BAR;
            PG8_LDB(B0, 1, 0); PG8_SCHED; PG8_LDA(At, 1, 0); PG8_STAGE(PG8_SA(0, 1), a2 + hstep, voffA);
            PG8_WAIT_L(8); PG8_BAR; PG8_WAIT_L(0); PG8_MMA(0, 0, At, B0); PG8_BAR; PG8_SCHED;
            PG8_LDB(B1, 1, 1); PG8_STAGE(PG8_SB(1, 0), b3, voffB);
            PG8_BAR; PG8_WAIT_L(0); PG8_MMA(0, 1, At, B1); PG8_BAR;
            PG8_LDA(At, 1, 1); PG8_STAGE(PG8_SA(1, 0), a3, voffA);
            PG8_BAR; PG8_WAIT_L(0); PG8_MMA(1, 0, At, B0); PG8_BAR; PG8_SCHED;
            PG8_STAGE(PG8_SB(1, 1), b3 + hstep, voffB);
            PG8_WAIT_V(6); PG8_BAR; PG8_MMA(1, 1, At, B1); PG8_BAR;
            }
        }
        if constexpr (ALIGN_EPI) { if (wr == 0) PG8_BAR; }
        if constexpr (!Epi::AFTER_DRAIN) { E(acc, cur, wr, wc, fr, fq); S.done(cur); }
        if (!has_next) break;
#pragma unroll
        for (int a = 0; a < 2; ++a)
#pragma unroll
            for (int b = 0; b < 2; ++b)
#pragma unroll
                for (int m = 0; m < 4; ++m)
#pragma unroll
                    for (int n = 0; n < 2; ++n) acc[a][b][m][n] = (f32x4){0.f, 0.f, 0.f, 0.f};
        cur = nxt; cA = nA; cB = nB; ++ui;
        if constexpr (ALIGN_EPI) { if (wr == 1) PG8_BAR; }
    }
    PG8_WAIT_V(0);
    if constexpr (!ALIGN_EPI) { if (wr == 0) PG8_BAR; }
    PG8_BAR;
    if constexpr (Epi::AFTER_DRAIN) { E.fused(acc, cur, wr, wc, fr, fq, lds, wid, lane); S.done(cur); }
#undef PG8_SA
#undef PG8_SB
#undef PG8_STAGE
#undef PG8_LDA
#undef PG8_LDB
#undef PG8_MMA
#undef PG8_WAIT_V
#undef PG8_WAIT_L
#undef PG8_BAR
#undef PG8_SCHED
}
}

constexpr int BATCH = 8, SEQ = 8192, DM = 1024, MROWS = BATCH * SEQ, NIN = 1792, FF = 4096;
constexpr int COL_K = 512, COL_V = 640, COL_U = 768, COL_VG = 1280;
constexpr float ALPHA = 1.18920711500272f;
constexpr float LN_EPS = 1e-5f, LOG2E = 1.4426950408889634f, QSCALE = 0.125f * LOG2E;
constexpr int NWAVES = 8, NTHREADS = NWAVES * 64;
constexpr int LDS_BYTES = 147456;
#ifndef MK_N_LAUNCHES
#define MK_N_LAUNCHES 1
#endif
constexpr int N_PHASES = 8;

constexpr size_t MiB = 1u << 20;
constexpr size_t WS_WIN = 2 * MiB, WS_WOUT = 6 * MiB, WS_WF1 = 8 * MiB, WS_WF2 = 16 * MiB, WS_WSP = 24 * MiB;
constexpr size_t WS_X1 = 32 * MiB;
constexpr size_t WS_XB = 160 * MiB;
constexpr size_t WS_PROJ = 288 * MiB;
constexpr size_t WS_MIX = 512 * MiB;
constexpr size_t WS_H = 512 * MiB;
constexpr size_t WS_END = 1024 * MiB;

typedef unsigned short bf16_t;
typedef short bf16x8 __attribute__((ext_vector_type(8)));
typedef short s16x4 __attribute__((ext_vector_type(4)));
typedef float f32x4 __attribute__((ext_vector_type(4)));
typedef float f32x16 __attribute__((ext_vector_type(16)));
typedef unsigned u32x4 __attribute__((ext_vector_type(4)));
typedef unsigned u32x2 __attribute__((ext_vector_type(2)));
#define LAS __attribute__((address_space(3)))
using pg8::cvtpk;
__device__ __forceinline__ float bflo(unsigned w) { return __uint_as_float(w << 16); }
__device__ __forceinline__ float bfhi(unsigned w) { return __uint_as_float(w & 0xffff0000u); }
__device__ __forceinline__ float wave_sum(float v) {
#pragma unroll
    for (int o = 1; o < 64; o <<= 1) v += __shfl_xor(v, o);
    return v;
}

__device__ __forceinline__ void p0_transpose_item(const float* W, int K, int N, bf16_t* WT, LAS float* scr, int item, int lane) {
    const int nblk = N / 32, kb = item / nblk, nb = item % nblk, k0 = 64 * kb, n0 = 32 * nb;
#pragma unroll 8
    for (int i = 0; i < 32; ++i) { const int kk = 2 * i + (lane >> 5); scr[kk * 33 + (lane & 31)] = W[(size_t)(k0 + kk) * N + n0 + (lane & 31)]; }
    asm volatile("s_waitcnt lgkmcnt(0)" ::: "memory");
    const int c = lane & 7;
#pragma unroll
    for (int j = 0; j < 4; ++j) { const int n = (lane >> 3) + 8 * j; const LAS float* s = scr + (8 * c) * 33 + n;
        u32x4 o; o.x = cvtpk(s[0 * 33], s[1 * 33]); o.y = cvtpk(s[2 * 33], s[3 * 33]); o.z = cvtpk(s[4 * 33], s[5 * 33]); o.w = cvtpk(s[6 * 33], s[7 * 33]);
        *(u32x4*)(WT + (size_t)(n0 + n) * K + k0 + 8 * c) = o; }
    asm volatile("s_waitcnt lgkmcnt(0)" ::: "memory");
}
__device__ __forceinline__ void row_to_bf16(const float* xrow, bf16_t* orow, int lane) {
    const f32x4* xr = (const f32x4*)xrow + lane; u32x2* o8 = (u32x2*)orow + lane;
    f32x4 v[4];
#pragma unroll
    for (int j = 0; j < 4; ++j) v[j] = xr[64 * j];
#pragma unroll
    for (int j = 0; j < 4; ++j) { u32x2 w; w.x = cvtpk(v[j].x, v[j].y); w.y = cvtpk(v[j].z, v[j].w); o8[64 * j] = w; }
}
__device__ __forceinline__ void ln_row(const float* xrow, const f32x4 (&g)[4], const f32x4 (&b)[4], bf16_t* oh, float* of, int lane) {
    const f32x4* xr = (const f32x4*)xrow + lane;
    f32x4 v[4]; float s = 0.f;
#pragma unroll
    for (int j = 0; j < 4; ++j) { v[j] = xr[64 * j]; s += (v[j].x + v[j].y) + (v[j].z + v[j].w); }
    const float mean = wave_sum(s) * (1.f / DM); float s2 = 0.f;
#pragma unroll
    for (int j = 0; j < 4; ++j) { v[j] = v[j] - mean; s2 += (v[j].x * v[j].x + v[j].y * v[j].y) + (v[j].z * v[j].z + v[j].w * v[j].w); }
    const float rstd = 1.f / sqrtf(wave_sum(s2) * (1.f / DM) + LN_EPS);
#pragma unroll
    for (int j = 0; j < 4; ++j) { const f32x4 o = v[j] * rstd * g[j] + b[j];
        if (oh) { u32x2 w; w.x = cvtpk(o.x, o.y); w.y = cvtpk(o.z, o.w); ((u32x2*)oh + lane)[64 * j] = w; }
        else ((f32x4*)of + lane)[64 * j] = o; }
}

namespace mix {
constexpr int KS = 144, VS = 192;
constexpr int OFF_K = 0, OFF_V = 384 * KS;
constexpr int VNS = 1088;
constexpr int OFF_SSQA = 128 * VNS;
constexpr int OFF_SSQ8 = OFF_SSQA + 1024;
static_assert(OFF_V + 384 * VS <= OFF_SSQA && OFF_SSQ8 + 4096 <= LDS_BYTES, "P2 LDS map");

__device__ __forceinline__ bf16x8 tr_frag(const LAS unsigned char* p0, const LAS unsigned char* p1) {
    const s16x4 lo = __builtin_bit_cast(s16x4, __builtin_amdgcn_ds_read_tr16_b64_v4i16((LAS s16x4*)p0));
    const s16x4 hi = __builtin_bit_cast(s16x4, __builtin_amdgcn_ds_read_tr16_b64_v4i16((LAS s16x4*)p1));
    return (bf16x8){lo[0], lo[1], lo[2], lo[3], hi[0], hi[1], hi[2], hi[3]};
}
#define MFMA32(a, b, c) __builtin_amdgcn_mfma_f32_32x32x16_bf16((a), (b), (c), 0, 0, 0)

__device__ __forceinline__ void attn_unit(LAS unsigned char* lds, const bf16_t* __restrict__ proj, bf16_t* __restrict__ mixed, const float* __restrict__ sink, const float* __restrict__ ga, int b, int n) {
    const int tid = threadIdx.x, lane = tid & 63, r32 = lane & 31, h = lane >> 5, wid = __builtin_amdgcn_readfirstlane(tid >> 6), qs = wid & 3, hp = wid >> 2;
    const size_t row0 = (size_t)b * SEQ + (size_t)n * 128;
    const int qrel = 32 * qs + r32;
    const bf16_t* qrow = proj + (row0 + qrel) * NIN;
    const int grp = lane >> 4, i16 = lane & 15, qq = i16 >> 2, pp = i16 & 3;
    const int vlane = (4 * h + qq) * VS + (16 * (grp & 1) + 4 * pp) * 2;
    const int klane = r32 * KS + h * 16;
    unsigned held[4][16]; float ssq = 0.f;
#pragma unroll
    for (int g = 0; g < 2; ++g) {
        __syncthreads();
#pragma unroll
        for (int i = 0; i < 6; ++i) { const int c = tid + NTHREADS * i, j = c >> 3, ch = c & 7, kpos = n * 128 - 128 + j;
            u32x4 kv = {0u, 0u, 0u, 0u}, vv = {0u, 0u, 0u, 0u};
            if (kpos >= 0 && kpos < SEQ) { const bf16_t* src = proj + ((size_t)b * SEQ + kpos) * NIN + COL_K + g * 64 + ch * 8; kv = *(const u32x4*)src; vv = *(const u32x4*)(src + (COL_V - COL_K)); }
            *(LAS u32x4*)(lds + OFF_K + j * KS + ch * 16) = kv; *(LAS u32x4*)(lds + OFF_V + j * VS + ch * 16) = vv; }
        __syncthreads();
#pragma unroll
        for (int hh = 0; hh < 2; ++hh) {
            const int head = 4 * g + 2 * hp + hh;
            bf16x8 qr[4];
#pragma unroll
            for (int d0 = 0; d0 < 4; ++d0) qr[d0] = *(const bf16x8*)(qrow + head * 64 + d0 * 16 + h * 8);
            float m = sink[head] * LOG2E, l = (h == 0) ? 1.f : 0.f;
            f32x16 o0 = {}, o1 = {};
            const float slope2 = __builtin_amdgcn_exp2f(-(float)(head + 1)) * LOG2E;
            for (int kt = 0; kt < 9; ++kt) {
                const int j0 = 32 * (qs + kt);
                f32x16 p = {};
                const LAS unsigned char* kp = lds + OFF_K + j0 * KS + klane;
#pragma unroll
                for (int d0 = 0; d0 < 4; ++d0) { const bf16x8 kf = *(const LAS bf16x8*)(kp + d0 * 32); p = MFMA32(kf, qr[d0], p); }
                float tm = -1e30f;
#pragma unroll
                for (int r = 0; r < 16; ++r) { const int krel = j0 + (r & 3) + 8 * (r >> 2) + 4 * h - 128; const int dd = qrel - krel, dist = dd < 0 ? -dd : dd; const int kabs = n * 128 + krel;
                    const bool valid = (dist <= 128) && (kabs >= 0) && (kabs < SEQ);
                    const float s = valid ? p[r] - slope2 * (float)dist : -1e30f; p[r] = s; tm = fmaxf(tm, s); }
                tm = fmaxf(tm, __shfl_xor(tm, 32));
                const float mn = fmaxf(m, tm), f = __builtin_amdgcn_exp2f(m - mn); m = mn; l *= f;
#pragma unroll
                for (int r = 0; r < 16; ++r) { o0[r] *= f; o1[r] *= f; }
                float ls = 0.f;
#pragma unroll
                for (int r = 0; r < 16; ++r) { p[r] = __builtin_amdgcn_exp2f(p[r] - m); ls += p[r]; }
                l += ls;
                u32x4 w0, w1;
                w0.x = cvtpk(p[0], p[1]); w0.y = cvtpk(p[2], p[3]); w0.z = cvtpk(p[4], p[5]); w0.w = cvtpk(p[6], p[7]);
                w1.x = cvtpk(p[8], p[9]); w1.y = cvtpk(p[10], p[11]); w1.z = cvtpk(p[12], p[13]); w1.w = cvtpk(p[14], p[15]);
                const bf16x8 pb0 = __builtin_bit_cast(bf16x8, w0), pb1 = __builtin_bit_cast(bf16x8, w1);
                const LAS unsigned char* vp = lds + OFF_V + j0 * VS + vlane;
                o0 = MFMA32(tr_frag(vp, vp + 8 * VS), pb0, o0);
                o1 = MFMA32(tr_frag(vp + 64, vp + 8 * VS + 64), pb0, o1);
                o0 = MFMA32(tr_frag(vp + 16 * VS, vp + 24 * VS), pb1, o0);
                o1 = MFMA32(tr_frag(vp + 16 * VS + 64, vp + 24 * VS + 64), pb1, o1);
            }
            l += __shfl_xor(l, 32);
            const float inv = 1.f / l;
#pragma unroll
            for (int r = 0; r < 16; ++r) { o0[r] *= inv; o1[r] *= inv; ssq += o0[r] * o0[r] + o1[r] * o1[r]; }
#pragma unroll
            for (int r = 0; r < 8; ++r) { held[g * 2 + hh][r] = cvtpk(o0[2 * r], o0[2 * r + 1]); held[g * 2 + hh][8 + r] = cvtpk(o1[2 * r], o1[2 * r + 1]); }
        }
    }
    ssq += __shfl_xor(ssq, 32);
    LAS float* ssqA = (LAS float*)(lds + OFF_SSQA);
    if (h == 0) ssqA[hp * 128 + qrel] = ssq;
    __syncthreads();
    const float tot = ssqA[qrel] + ssqA[128 + qrel]; const float rstd = 1.f / sqrtf(tot * (1.f / 512.f) + LN_EPS);
    bf16_t* orow = mixed + (row0 + qrel) * DM;
#pragma unroll
    for (int x = 0; x < 4; ++x) { const int head = 4 * (x >> 1) + 2 * hp + (x & 1);
#pragma unroll
        for (int db = 0; db < 2; ++db)
#pragma unroll
            for (int rq = 0; rq < 4; ++rq) { const int d = head * 64 + 32 * db + 8 * rq + 4 * h; const f32x4 g4 = *(const f32x4*)(ga + d);
                const unsigned wa = held[x][db * 8 + 2 * rq], wb = held[x][db * 8 + 2 * rq + 1];
                u32x2 w; w.x = cvtpk(bflo(wa) * rstd * g4.x, bfhi(wa) * rstd * g4.y); w.y = cvtpk(bflo(wb) * rstd * g4.z, bfhi(wb) * rstd * g4.w);
                *(u32x2*)(orow + d) = w; } }
}

template <bool STORE>
__device__ __forceinline__ void sgu_pass(LAS unsigned char* lds, const bf16_t* __restrict__ proj, bf16_t* __restrict__ mixed, const bf16_t* __restrict__ wsb, const float* __restrict__ bsp, const float* __restrict__ gn, size_t row0) {
    const int tid = threadIdx.x, lane = tid & 63, r32 = lane & 31, h = lane >> 5, g = __builtin_amdgcn_readfirstlane(tid >> 6);
    const int grp = lane >> 4, i16 = lane & 15, qq = i16 >> 2, pp = i16 & 3;
    const int vnlane = (8 * h + qq) * VNS + (64 * g + 16 * (grp & 1) + 4 * pp) * 2;
    LAS float* ssq8 = (LAS float*)(lds + OFF_SSQ8);
    for (int tb = 0; tb < 4; ++tb) {
        const int t = 32 * tb + r32;
        f32x16 a0 = {}, a1 = {};
        const bf16_t* wrow = wsb + (size_t)(g * 128 + t) * 128 + 8 * h;
#pragma unroll
        for (int ks = 0; ks < 8; ++ks) { const bf16x8 wf = *(const bf16x8*)(wrow + 16 * ks); const LAS unsigned char* vp = lds + ks * 16 * VNS + vnlane;
            a0 = MFMA32(tr_frag(vp, vp + 4 * VNS), wf, a0); a1 = MFMA32(tr_frag(vp + 64, vp + 4 * VNS + 64), wf, a1); }
        const float bs = bsp[g * 128 + t];
        const bf16_t* gurow = proj + (row0 + t) * NIN + COL_U + 64 * g;
        float rstd = 0.f;
        if (STORE) { float tot = 0.f;
#pragma unroll
            for (int gg = 0; gg < 8; ++gg) tot += ssq8[gg * 128 + t];
            rstd = 1.f / sqrtf(tot * (1.f / 512.f) + LN_EPS); }
        float ss = 0.f;
#pragma unroll
        for (int db = 0; db < 2; ++db)
#pragma unroll
            for (int rq = 0; rq < 4; ++rq) { const int c = 32 * db + 8 * rq + 4 * h; const u32x2 w = *(const u32x2*)(gurow + c);
                const f32x16& a = db ? a1 : a0;
                const float v0 = bflo(w.x) * (a[4 * rq + 0] + bs), v1 = bfhi(w.x) * (a[4 * rq + 1] + bs), v2 = bflo(w.y) * (a[4 * rq + 2] + bs), v3 = bfhi(w.y) * (a[4 * rq + 3] + bs);
                if (STORE) { const f32x4 g4 = *(const f32x4*)(gn + 64 * g + c); u32x2 o; o.x = cvtpk(v0 * rstd * g4.x, v1 * rstd * g4.y); o.y = cvtpk(v2 * rstd * g4.z, v3 * rstd * g4.w);
                    *(u32x2*)(mixed + (row0 + t) * DM + 512 + 64 * g + c) = o; }
                else ss += (v0 * v0 + v1 * v1) + (v2 * v2 + v3 * v3); }
        if (!STORE) { ss += __shfl_xor(ss, 32); if (h == 0) ssq8[g * 128 + t] = ss; }
    }
}
__device__ __forceinline__ void sgu_unit(LAS unsigned char* lds, const bf16_t* __restrict__ proj, bf16_t* __restrict__ mixed, const float* __restrict__ lng, const float* __restrict__ lnb,
                                         const bf16_t* __restrict__ wsb, const float* __restrict__ bsp, const float* __restrict__ gn, int b, int n) {
    const int tid = threadIdx.x, lane = tid & 63, wid = __builtin_amdgcn_readfirstlane(tid >> 6);
    const size_t row0 = (size_t)b * SEQ + (size_t)n * 128;
    __syncthreads();
    { const f32x4 ga = *(const f32x4*)(lng + lane * 8), gb = *(const f32x4*)(lng + lane * 8 + 4), ba = *(const f32x4*)(lnb + lane * 8), bb = *(const f32x4*)(lnb + lane * 8 + 4);
      for (int i = 0; i < 16; ++i) { const int t = wid * 16 + i; const u32x4 w = *(const u32x4*)(proj + (row0 + t) * NIN + COL_VG + lane * 8);
        float v[8] = {bflo(w.x), bfhi(w.x), bflo(w.y), bfhi(w.y), bflo(w.z), bfhi(w.z), bflo(w.w), bfhi(w.w)};
        float s = 0.f;
#pragma unroll
        for (int k = 0; k < 8; ++k) s += v[k];
        const float mean = wave_sum(s) * (1.f / 512.f); float s2 = 0.f;
#pragma unroll
        for (int k = 0; k < 8; ++k) { v[k] -= mean; s2 += v[k] * v[k]; }
        const float rstd = 1.f / sqrtf(wave_sum(s2) * (1.f / 512.f) + LN_EPS);
        u32x4 o; o.x = cvtpk(v[0] * rstd * ga.x + ba.x, v[1] * rstd * ga.y + ba.y); o.y = cvtpk(v[2] * rstd * ga.z + ba.z, v[3] * rstd * ga.w + ba.w);
        o.z = cvtpk(v[4] * rstd * gb.x + bb.x, v[5] * rstd * gb.y + bb.y); o.w = cvtpk(v[6] * rstd * gb.z + bb.z, v[7] * rstd * gb.w + bb.w);
        *(LAS u32x4*)(lds + t * VNS + lane * 16) = o; } }
    __syncthreads();
    sgu_pass<false>(lds, proj, mixed, wsb, bsp, gn, row0);
    __syncthreads();
    sgu_pass<true>(lds, proj, mixed, wsb, bsp, gn, row0);
}
}

struct Args { const float* in[16]; float* out; unsigned char* ws; int ph_lo, ph_hi; };
__global__ void __launch_bounds__(NTHREADS, 2) fwd_kernel(Args args) {
    extern __shared__ __attribute__((aligned(16))) unsigned char lds_raw[];
    LAS unsigned char* lds = (LAS unsigned char*)lds_raw;
    cg::grid_group grid = cg::this_grid();
    const int tid = threadIdx.x, lane = tid & 63, wave = __builtin_amdgcn_readfirstlane(tid >> 6);
    const int G = gridDim.x, bx = blockIdx.x;
    const int vcu = (G % 8 == 0) ? (bx % 8) * (G / 8) + bx / 8 : bx;
    const int gw = vcu * NWAVES + wave, NGW = G * NWAVES;
    unsigned char* ws = args.ws;
    const float* x = args.in[0]; const float* w_in = args.in[1]; const float* sink = args.in[2]; const float* lng = args.in[3]; const float* lnb = args.in[4];
    const float* w_sp = args.in[5]; const float* b_sp = args.in[6]; const float* ga = args.in[7]; const float* gn = args.in[8]; const float* w_out = args.in[9];
    const float* ln1g = args.in[10]; const float* ln1b = args.in[11]; const float* w_f1 = args.in[12]; const float* w_f2 = args.in[13]; const float* ln2g = args.in[14]; const float* ln2b = args.in[15];
    bf16_t* WIN = (bf16_t*)(ws + WS_WIN); bf16_t* WOUT = (bf16_t*)(ws + WS_WOUT); bf16_t* WF1 = (bf16_t*)(ws + WS_WF1); bf16_t* WF2 = (bf16_t*)(ws + WS_WF2); bf16_t* WSP = (bf16_t*)(ws + WS_WSP);
    bf16_t* X1 = (bf16_t*)(ws + WS_X1); bf16_t* XB = (bf16_t*)(ws + WS_XB); bf16_t* PROJ = (bf16_t*)(ws + WS_PROJ); bf16_t* MIX = (bf16_t*)(ws + WS_MIX); bf16_t* HB = (bf16_t*)(ws + WS_H);
    float* out = args.out;
    const int lo = args.ph_lo, hi = args.ph_hi;
#define IN(k) (lo <= (k) && (k) < hi)
#define SEAM(k) do { if (IN(k) && IN((k) + 1)) grid.sync(); } while (0)

    if (IN(0)) {
        LAS float* scr = (LAS float*)(lds + wave * 16384);
        constexpr int I_IN = (DM / 64) * (NIN / 32), I_OUT = (DM / 64) * (DM / 32), I_F1 = (DM / 64) * (FF / 32), I_F2 = (FF / 64) * (DM / 32), I_SP = 8 * 128 * 128 / 512;
        constexpr int NITEMS = I_IN + I_OUT + I_F1 + I_F2 + I_SP;
        for (int it = gw; it < NITEMS; it += NGW) {
            int r = it;
            if (r < I_IN) { p0_transpose_item(w_in, DM, NIN, WIN, scr, r, lane); continue; } r -= I_IN;
            if (r < I_OUT) { p0_transpose_item(w_out, DM, DM, WOUT, scr, r, lane); continue; } r -= I_OUT;
            if (r < I_F1) { p0_transpose_item(w_f1, DM, FF, WF1, scr, r, lane); continue; } r -= I_F1;
            if (r < I_F2) { p0_transpose_item(w_f2, FF, DM, WF2, scr, r, lane); continue; } r -= I_F2;
            { const size_t e = (size_t)r * 512 + lane * 8; const f32x4 a = *(const f32x4*)(w_sp + e), b = *(const f32x4*)(w_sp + e + 4);
              u32x4 o; o.x = cvtpk(a.x, a.y); o.y = cvtpk(a.z, a.w); o.z = cvtpk(b.x, b.y); o.w = cvtpk(b.z, b.w); *(u32x4*)(WSP + e) = o; }
        }
        for (int m = gw; m < MROWS; m += NGW) row_to_bf16(x + (size_t)m * DM, XB + (size_t)m * DM, lane);
    }
    SEAM(0);
    if (IN(1)) {
        pg8::Gemm g{XB, WIN, MROWS, NIN, DM}; pg8::StaticOrder S; S.init(MROWS, NIN, G, bx);
        pg8::EpiAct E{PROJ, NIN, 0, QSCALE};
        pg8::gemm_phase<pg8::EpiAct, pg8::StaticOrder, true, true>(lds, g, S, E);
    }
    SEAM(1);
    if (IN(2)) {
        constexpr int NU = BATCH * (SEQ / 128);
        const int per = (NU + G - 1) / G;
        for (int i = 0; i < per; ++i) { const int u = vcu * per + i; if (u >= NU) break;
            const int b = u / (SEQ / 128), n = u % (SEQ / 128);
            mix::attn_unit(lds, PROJ, MIX, sink, ga, b, n);
            mix::sgu_unit(lds, PROJ, MIX, lng, lnb, WSP, b_sp, gn, b, n); }
    }
    SEAM(2);
    if (IN(3)) {
        pg8::Gemm g{MIX, WOUT, MROWS, DM, DM}; pg8::StaticOrder S; S.init(MROWS, DM, G, bx);
        pg8::EpiRes E{x, nullptr, out, DM, ALPHA};
        pg8::gemm_phase<pg8::EpiRes, pg8::StaticOrder, true, true>(lds, g, S, E);
    }
    SEAM(3);
    if (IN(4)) {
        f32x4 g4[4], b4[4];
#pragma unroll
        for (int j = 0; j < 4; ++j) { g4[j] = ((const f32x4*)ln1g + lane)[64 * j]; b4[j] = ((const f32x4*)ln1b + lane)[64 * j]; }
        for (int m = gw; m < MROWS; m += NGW) ln_row(out + (size_t)m * DM, g4, b4, X1 + (size_t)m * DM, nullptr, lane);
    }
    SEAM(4);
    if (IN(5)) {
        pg8::Gemm g{X1, WF1, MROWS, FF, DM}; pg8::StaticOrder S; S.init(MROWS, FF, G, bx);
        pg8::EpiAct E{HB, FF, 1, 1.f};
        pg8::gemm_phase<pg8::EpiAct, pg8::StaticOrder, true, true>(lds, g, S, E);
    }
    SEAM(5);
    if (IN(6)) {
        pg8::Gemm g{HB, WF2, MROWS, DM, FF}; pg8::StaticOrder S; S.init(MROWS, DM, G, bx);
        pg8::EpiRes E{nullptr, X1, out, DM, ALPHA};
        pg8::gemm_phase<pg8::EpiRes, pg8::StaticOrder, true, true>(lds, g, S, E);
    }
    SEAM(6);
    if (IN(7)) {
        f32x4 g4[4], b4[4];
#pragma unroll
        for (int j = 0; j < 4; ++j) { g4[j] = ((const f32x4*)ln2g + lane)[64 * j]; b4[j] = ((const f32x4*)ln2b + lane)[64 * j]; }
        for (int m = gw; m < MROWS; m += NGW) ln_row(out + (size_t)m * DM, g4, b4, nullptr, out + (size_t)m * DM, lane);
    }
#undef IN
#undef SEAM
}

extern "C" void kernel_launch(void* const* d_in, const int* in_sizes, int n_in, void* d_out, int out_size, void* d_ws, size_t ws_size, hipStream_t stream) {
    static int grid = 0;
    if (grid == 0) {
        if (n_in != 16 || in_sizes[0] != MROWS * DM || out_size != MROWS * DM || ws_size < WS_END) {
            fprintf(stderr, "kernel_launch: unexpected shapes (n_in %d, in0 %d, out %d, ws %zu); nothing launched\n", n_in, n_in > 0 ? in_sizes[0] : -1, out_size, ws_size); grid = -1; return; }
        int dev = 0, cus = 0, per_cu = 0;
        if (hipGetDevice(&dev) != hipSuccess || hipDeviceGetAttribute(&cus, hipDeviceAttributeMultiprocessorCount, dev) != hipSuccess) { grid = -1; return; }
        if (hipFuncSetAttribute((const void*)fwd_kernel, hipFuncAttributeMaxDynamicSharedMemorySize, LDS_BYTES) != hipSuccess) { fprintf(stderr, "kernel_launch: hipFuncSetAttribute failed\n"); grid = -1; return; }
        if (hipOccupancyMaxActiveBlocksPerMultiprocessor(&per_cu, (const void*)fwd_kernel, NTHREADS, LDS_BYTES) != hipSuccess || per_cu < 1) { fprintf(stderr, "kernel_launch: occupancy query says %d blocks per CU\n", per_cu); per_cu = 1; }
        (void)hipGetLastError();
        grid = cus * per_cu;
    }
    if (grid < 0) return;
    Args a{};
    for (int i = 0; i < 16; ++i) a.in[i] = (const float*)d_in[i];
    a.out = (float*)d_out; a.ws = (unsigned char*)d_ws;
    if (MK_N_LAUNCHES == 1) {
        a.ph_lo = 0; a.ph_hi = N_PHASES;
        void* kargs[] = {&a};
        const hipError_t e = hipLaunchCooperativeKernel((const void*)fwd_kernel, dim3(grid), dim3(NTHREADS), kargs, LDS_BYTES, stream);
        if (e != hipSuccess) fprintf(stderr, "kernel_launch: cooperative launch failed: %s (grid %d)\n", hipGetErrorString(e), grid);
    } else {
        for (int k = 0; k < N_PHASES; ++k) { a.ph_lo = k; a.ph_hi = k + 1;
            hipLaunchKernelGGL(fwd_kernel, dim3(grid), dim3(NTHREADS), LDS_BYTES, stream, a); }
    }
}
```

```cpp
#include <hip/hip_runtime.h>
#include <hip/hip_cooperative_groups.h>
#include <cstdio>
#include <cstdint>
namespace cg = cooperative_groups;
#define MK_N_LAUNCHES 1
namespace pg8 {
#define PG8_LAS __attribute__((address_space(3)))
typedef unsigned short bf16_t;
typedef short bf16x8 __attribute__((ext_vector_type(8)));
typedef float f32x4 __attribute__((ext_vector_type(4)));
typedef unsigned u32x4 __attribute__((ext_vector_type(4)));
constexpr int BM = 256, BK = 64, HALF = 128, HTB = HALF * BK * 2  , STAGE_BYTES = 8 * HTB, NXCD = 8, WGM = 8;

__host__ __device__ __forceinline__ int lds_byte(int r, int c) { const int st = (r >> 4) * 2 + (c >> 5), rr = r & 15, cc = c & 31, ob = rr * 64 + cc * 2; return st * 1024 + (ob ^ (((ob >> 9) & 1) << 5)); }
__host__ __device__ __forceinline__ void stage_rc(int b, int& R, int& C) { const int st = b / 1024, sb = b % 1024, swz = sb ^ (((sb >> 9) & 1) << 5); R = (st >> 1) * 16 + swz / 64; C = (st & 1) * 32 + (swz % 64) / 2; }
__host__ __device__ __forceinline__ int perm32(int rho) { const int n = rho >> 4, i = rho & 15; return 8 * (i >> 2) + 4 * n + (i & 3); }

struct Unit { int pm, pn; };
struct Gemm { const bf16_t* A; const bf16_t* Bt; int M, N, K; };

struct StaticOrder {
    int nM, nN, nwg, G, c;
    __host__ __device__ void init(int M, int N, int G_, int c_) { nM = M / BM; nN = N / BM; nwg = nM * nN; G = G_; c = c_; }
    __host__ __device__ bool next(int i, Unit& u) const {
        const long L = (long)i * G + c; if (L >= nwg) return false;
        int wgid = (int)L; { const int q = nwg / NXCD, r = nwg % NXCD, xcd = wgid % NXCD, off = wgid / NXCD; wgid = (xcd < r ? xcd * (q + 1) : r * (q + 1) + (xcd - r) * q) + off; }
        const int nig = WGM * nN, gid = wgid / nig, fm = gid * WGM, gsz = (nM - fm) < WGM ? (nM - fm) : WGM;
        u.pm = fm + ((wgid % nig) % gsz); u.pn = (wgid % nig) / gsz; return true;
    }
    __device__ __forceinline__ void a_ready(const Unit&) const {}
    __device__ __forceinline__ void done(const Unit&) const {}
};

__device__ __forceinline__ unsigned cvt_pk_bf16(float lo, float hi) { unsigned r; asm volatile("v_cvt_pk_bf16_f32 %0, %1, %2" : "=v"(r) : "v"(lo), "v"(hi)); return r; }
typedef float f32x2 __attribute__((ext_vector_type(2)));
__device__ __forceinline__ f32x2 gelu_pk(f32x2 v) {
    const f32x2 av = __builtin_elementwise_abs(v), d = av * 0.2316418882f + 1.0f;
    f32x2 t; t.x = __builtin_amdgcn_rcpf(d.x); t.y = __builtin_amdgcn_rcpf(d.y);
    f32x2 q = t * 0.5307027145f + (-0.7265760135f); q = q * t + 0.7107068705f; q = q * t + (-0.142248368f); q = q * t + 0.127414796f; q = q * t;
    const f32x2 s = (v * v) * (-0.72134752044f);
    f32x2 e; e.x = __builtin_amdgcn_exp2f(s.x); e.y = __builtin_amdgcn_exp2f(s.y);
    const f32x2 m = v * (q * e), r = v - m;
    f32x2 o; o.x = v.x < 0.f ? m.x : r.x; o.y = v.y < 0.f ? m.y : r.y; return o;
}
typedef unsigned u32x2 __attribute__((ext_vector_type(2)));
typedef __bf16 bf16x2_t __attribute__((ext_vector_type(2)));
__device__ __forceinline__ unsigned cvtpk(float lo, float hi) { f32x2 v = {lo, hi}; bf16x2_t b = __builtin_convertvector(v, bf16x2_t); return __builtin_bit_cast(unsigned, b); }
struct EpiAct {
    static constexpr bool PERM = true, AFTER_DRAIN = false;
    bf16_t* O; int ldc; int mode; float q_scale;
    __device__ __forceinline__ void operator()(const f32x4 (&acc)[2][2][4][2], const Unit& u, int wr, int wc, int fr, int fq) const {
        const int row0 = u.pm * BM + wr * 64 + fr; const int col0 = u.pn * BM + wc * 32 + 8 * fq;
        int act = 2; float sc = 1.f;
        if (mode == 0) { act = (u.pn >= 3) ? 1 : 0; sc = (u.pn < 2) ? q_scale : 1.f; }
#pragma unroll
        for (int ai = 0; ai < 2; ++ai)
#pragma unroll
            for (int m = 0; m < 4; ++m) { bf16_t* rowp = O + (size_t)(row0 + ai * HALF + m * 16) * ldc + col0;
#pragma unroll
                for (int bj = 0; bj < 2; ++bj) { f32x4 v0 = acc[ai][bj][m][0], v1 = acc[ai][bj][m][1];
                    if (act == 1) { f32x2 a = gelu_pk((f32x2){v0[0], v0[1]}), b = gelu_pk((f32x2){v0[2], v0[3]}), c = gelu_pk((f32x2){v1[0], v1[1]}), d = gelu_pk((f32x2){v1[2], v1[3]});
                        v0 = (f32x4){a.x, a.y, b.x, b.y}; v1 = (f32x4){c.x, c.y, d.x, d.y}; }
                    else if (act == 2) {
#pragma unroll
                        for (int k = 0; k < 4; ++k) { const float a = fmaxf(v0[k], 0.f), b = fmaxf(v1[k], 0.f); v0[k] = a * a; v1[k] = b * b; } }
                    else { v0 = v0 * sc; v1 = v1 * sc; }
                    u32x4 w; w.x = cvtpk(v0[0], v0[1]); w.y = cvtpk(v0[2], v0[3]); w.z = cvtpk(v1[0], v1[1]); w.w = cvtpk(v1[2], v1[3]);
                    *(u32x4*)(rowp + bj * HALF) = w; } }
    }
};
struct EpiRes {
    static constexpr bool PERM = false, AFTER_DRAIN = false;
    const float* basef; const bf16_t* baseh; float* out; int ldc; float alpha;
    __device__ __forceinline__ void operator()(const f32x4 (&acc)[2][2][4][2], const Unit& u, int wr, int wc, int fr, int fq) const {
        const int row0 = u.pm * BM + wr * 64 + fr; const int col0 = u.pn * BM + wc * 32 + 4 * fq;
#pragma unroll
        for (int ai = 0; ai < 2; ++ai)
#pragma unroll
            for (int m = 0; m < 4; ++m) { const size_t off = (size_t)(row0 + ai * HALF + m * 16) * ldc + col0;
#pragma unroll
                for (int bj = 0; bj < 2; ++bj)
#pragma unroll
                    for (int n = 0; n < 2; ++n) { const size_t c = off + bj * HALF + n * 16; f32x4 bs;
                        if (basef) bs = *(const f32x4*)(basef + c);
                        else { const u32x2 w = *(const u32x2*)(baseh + c); bs = (f32x4){__uint_as_float(w.x << 16), __uint_as_float(w.x & 0xffff0000u), __uint_as_float(w.y << 16), __uint_as_float(w.y & 0xffff0000u)}; }
                        *(f32x4*)(out + c) = bs * alpha + acc[ai][bj][m][n]; }
                asm volatile("" ::: "memory"); }
    }
};
template <class Epi, class Sched, bool ALIGN_EPI = false, bool SP2 = false>
__device__ __forceinline__ void gemm_phase(PG8_LAS unsigned char* lds, const Gemm g, const Sched& S, const Epi& E) {
    const int tid = threadIdx.x, wid = __builtin_amdgcn_readfirstlane(tid >> 6), lane = tid & 63, wr = wid >> 2, wc = wid & 3, fr = lane & 15, fq = lane >> 4;
    const int K = g.K, nt = K / BK;
    unsigned voffA[2], voffB[2];
#pragma unroll
    for (int i = 0; i < 2; ++i) { int R, C; stage_rc(tid * 16 + i * 8192, R, C); const int Rb = Epi::PERM ? ((R & ~31) + perm32(R & 31)) : R;
        voffA[i] = (unsigned)(R * K + C) * 2u; voffB[i] = (unsigned)(Rb * K + C) * 2u; }
    const size_t kstep = (size_t)(BK * 2);
    const size_t hstep = (size_t)HALF * K * 2;
    const size_t tstep = 2 * hstep;
    const unsigned ldsw = (unsigned)wid * 1024u;
    const int aoff = lds_byte(wr * 64 + fr, fq * 8), boff = lds_byte(wc * 32 + fr, fq * 8);
#define PG8_SA(b, h) (((b) * 2 + (h)) * HTB)
#define PG8_SB(b, h) ((4 + (b) * 2 + (h)) * HTB)
#define PG8_STAGE(bufoff, gbase, voff) do { _Pragma("unroll") for (int _i = 0; _i < 2; ++_i) \
        __builtin_amdgcn_global_load_lds((const unsigned*)((const char*)(gbase) + (voff)[_i]), (PG8_LAS unsigned*)(lds + (bufoff) + ldsw + _i * 8192), 16, 0, 0); } while (0)
#define PG8_LDA(dst, b, h) do { _Pragma("unroll") for (int m = 0; m < 4; ++m) _Pragma("unroll") for (int k = 0; k < 2; ++k) dst[m][k] = *(const PG8_LAS bf16x8*)(lds + PG8_SA(b, h) + aoff + m * 2048 + k * 1024); } while (0)
#define PG8_LDB(dst, b, h) do { _Pragma("unroll") for (int n = 0; n < 2; ++n) _Pragma("unroll") for (int k = 0; k < 2; ++k) dst[n][k] = *(const PG8_LAS bf16x8*)(lds + PG8_SB(b, h) + boff + n * 2048 + k * 1024); } while (0)
#define PG8_MMA(ai, bj, At, Bt) do { __builtin_amdgcn_s_setprio(1); _Pragma("unroll") for (int m = 0; m < 4; ++m) _Pragma("unroll") for (int n = 0; n < 2; ++n) _Pragma("unroll") for (int k = 0; k < 2; ++k) \
        acc[ai][bj][m][n] = __builtin_amdgcn_mfma_f32_16x16x32_bf16(Bt[n][k], At[m][k], acc[ai][bj][m][n], 0, 0, 0); __builtin_amdgcn_s_setprio(0); } while (0)
#define PG8_WAIT_V(n) asm volatile("s_waitcnt vmcnt(" #n ")" ::: "memory")
#define PG8_WAIT_L(n) asm volatile("s_waitcnt lgkmcnt(" #n ")" ::: "memory")
#define PG8_BAR __builtin_amdgcn_s_barrier()
#define PG8_SCHED __builtin_amdgcn_sched_barrier(0)
    Unit cur, nxt; int ui = 0;
    if (!S.next(0, cur)) return;
    f32x4 acc[2][2][4][2];
#pragma unroll
    for (int a = 0; a < 2; ++a)
#pragma unroll
        for (int b = 0; b < 2; ++b)
#pragma unroll
            for (int m = 0; m < 4; ++m)
#pragma unroll
                for (int n = 0; n < 2; ++n) acc[a][b][m][n] = (f32x4){0.f, 0.f, 0.f, 0.f};
    bf16x8 At[4][2], B0[2][2], B1[2][2];
    const char* cA = (const char*)g.A + (size_t)cur.pm * tstep; const char* cB = (const char*)g.Bt + (size_t)cur.pn * tstep;
    S.a_ready(cur);
    if constexpr (SP2) {
        PG8_STAGE(PG8_SB(0, 0), cB, voffB); PG8_STAGE(PG8_SB(0, 1), cB + hstep, voffB); PG8_STAGE(PG8_SA(0, 0), cA, voffA); PG8_STAGE(PG8_SA(0, 1), cA + hstep, voffA);
        if (wr == 1) PG8_BAR;
        PG8_WAIT_V(2); PG8_BAR;
        PG8_STAGE(PG8_SB(1, 0), cB + kstep, voffB); PG8_STAGE(PG8_SA(1, 0), cA + kstep, voffA); PG8_STAGE(PG8_SB(1, 1), cB + hstep + kstep, voffB);
        PG8_WAIT_V(6); PG8_BAR;
    } else {
        PG8_STAGE(PG8_SB(0, 0), cB, voffB); PG8_STAGE(PG8_SA(0, 0), cA, voffA); PG8_STAGE(PG8_SB(0, 1), cB + hstep, voffB); PG8_STAGE(PG8_SA(0, 1), cA + hstep, voffA);
        if (wr == 1) PG8_BAR;
        PG8_WAIT_V(4); PG8_BAR;
        PG8_STAGE(PG8_SB(1, 0), cB + kstep, voffB); PG8_STAGE(PG8_SA(1, 0), cA + kstep, voffA); PG8_STAGE(PG8_SB(1, 1), cB + hstep + kstep, voffB);
        PG8_WAIT_V(6); PG8_BAR;
    }
    for (;;) {
        const bool has_next = S.next(ui + 1, nxt);
        const char* nA = has_next ? (const char*)g.A + (size_t)nxt.pm * tstep : cA; const char* nB = has_next ? (const char*)g.Bt + (size_t)nxt.pn * tstep : cB;
        for (int t = 0; t < nt; t += 2) {
            const bool last = (t == nt - 2);
            const char* a1 = cA + (size_t)(t + 1) * kstep;
            const char* a2 = last ? nA : cA + (size_t)(t + 2) * kstep; const char* b2 = last ? nB : cB + (size_t)(t + 2) * kstep;
            const char* a3 = a2 + kstep; const char* b3 = b2 + kstep;
            if (last && has_next) S.a_ready(nxt);
            if constexpr (SP2) {
            PG8_LDB(B0, 0, 0); PG8_LDB(B1, 0, 1); PG8_SCHED; PG8_LDA(At, 0, 0); PG8_STAGE(PG8_SA(1, 1), a1 + hstep, voffA);
            PG8_WAIT_V(8); PG8_WAIT_L(0); PG8_BAR; PG8_MMA(0, 0, At, B0); PG8_MMA(0, 1, At, B1); PG8_BAR; PG8_SCHED;
            PG8_LDA(At, 0, 1); PG8_STAGE(PG8_SB(0, 0), b2, voffB); PG8_STAGE(PG8_SB(0, 1), b2 + hstep, voffB); PG8_STAGE(PG8_SA(0, 0), a2, voffA);
            PG8_WAIT_V(8); PG8_WAIT_L(0); PG8_BAR; PG8_MMA(1, 0, At, B0); PG8_MMA(1, 1, At, B1); PG8_BAR; PG8_SCHED;
            PG8_LDB(B0, 1, 0); PG8_LDB(B1, 1, 1); PG8_SCHED; PG8_LDA(At, 1, 0); PG8_STAGE(PG8_SA(0, 1), a2 + hstep, voffA);
            PG8_WAIT_V(8); PG8_WAIT_L(0); PG8_BAR; PG8_MMA(0, 0, At, B0); PG8_MMA(0, 1, At, B1); PG8_BAR; PG8_SCHED;
            PG8_LDA(At, 1, 1); PG8_STAGE(PG8_SB(1, 0), b3, voffB); PG8_STAGE(PG8_SB(1, 1), b3 + hstep, voffB); PG8_STAGE(PG8_SA(1, 0), a3, voffA);
            PG8_WAIT_V(8); PG8_WAIT_L(0); PG8_BAR; PG8_MMA(1, 0, At, B0); PG8_MMA(1, 1, At, B1); PG8_BAR; PG8_SCHED;
            } else {
            PG8_LDB(B0, 0, 0); PG8_SCHED; PG8_LDA(At, 0, 0); PG8_STAGE(PG8_SA(1, 1), a1 + hstep, voffA);
            PG8_WAIT_L(8); PG8_BAR; PG8_WAIT_L(0); PG8_MMA(0, 0, At, B0); PG8_BAR; PG8_SCHED;
            PG8_LDB(B1, 0, 1); PG8_STAGE(PG8_SB(0, 0), b2, voffB);
            PG8_BAR; PG8_WAIT_L(0); PG8_MMA(0, 1, At, B1); PG8_BAR;
            PG8_LDA(At, 0, 1); PG8_STAGE(PG8_SA(0, 0), a2, voffA);
            PG8_BAR; PG8_WAIT_L(0); PG8_MMA(1, 0, At, B0); PG8_BAR; PG8_SCHED;
            PG8_STAGE(PG8_SB(0, 1), b2 + hstep, voffB);
            PG8_WAIT_V(6); PG8_BAR; PG8_MMA(1, 1, At, B1); PG8_BAR;
            PG8_LDB(B0, 1, 0); PG8_SCHED; PG8_LDA(At, 1, 0); PG8_STAGE(PG8_SA(0, 1), a2 + hstep, voffA);
            PG8_WAIT_L(8); PG8_BAR; PG8_WAIT_L(0); PG8_MMA(0, 0, At, B0); PG8_BAR; PG8_SCHED;
            PG8_LDB(B1, 1, 1); PG8_STAGE(PG8_SB(1, 0), b3, voffB);
            PG8_BAR; PG8_WAIT_L(0); PG8_MMA(0, 1, At, B1); PG8_BAR;
            PG8_LDA(At, 1, 1); PG8_STAGE(PG8_SA(1, 0), a3, voffA);
            PG8_BAR; PG8_WAIT_L(0); PG8_MMA(1, 0, At, B0); PG8_BAR; PG8_SCHED;
            PG8_STAGE(PG8_SB(1, 1), b3 + hstep, voffB);
            PG8_WAIT_V(6); PG8_BAR; PG8_MMA(1, 1, At, B1); PG8_BAR;
            }
        }
        if constexpr (ALIGN_EPI) { if (wr == 0) PG8_BAR; }
        if constexpr (!Epi::AFTER_DRAIN) { E(acc, cur, wr, wc, fr, fq); S.done(cur); }
        if (!has_next) break;
#pragma unroll
        for (int a = 0; a < 2; ++a)
#pragma unroll
            for (int b = 0; b < 2; ++b)
#pragma unroll
                for (int m = 0; m < 4; ++m)
#pragma unroll
                    for (int n = 0; n < 2; ++n) acc[a][b][m][n] = (f32x4){0.f, 0.f, 0.f, 0.f};
        cur = nxt; cA = nA; cB = nB; ++ui;
        if constexpr (ALIGN_EPI) { if (wr == 1) PG8_BAR; }
    }
    PG8_WAIT_V(0);
    if constexpr (!ALIGN_EPI) { if (wr == 0) PG8_BAR; }
    PG8_BAR;
    if constexpr (Epi::AFTER_DRAIN) { E.fused(acc, cur, wr, wc, fr, fq, lds, wid, lane); S.done(cur); }
#undef PG8_SA
#undef PG8_SB
#undef PG8_STAGE
#undef PG8_LDA
#undef PG8_LDB
#undef PG8_MMA
#undef PG8_WAIT_V
#undef PG8_WAIT_L
#undef PG8_BAR
#undef PG8_SCHED
}
}

constexpr int BATCH = 8, SEQ = 8192, DM = 1024, MROWS = BATCH * SEQ, NIN = 1792, FF = 4096;
constexpr int COL_K = 512, COL_V = 640, COL_U = 768, COL_VG = 1280;
constexpr float ALPHA = 1.18920711500272f;
constexpr float LN_EPS = 1e-5f, LOG2E = 1.4426950408889634f, QSCALE = 0.125f * LOG2E;
constexpr int NWAVES = 8, NTHREADS = NWAVES * 64;
constexpr int LDS_BYTES = 147456;
#ifndef MK_N_LAUNCHES
#define MK_N_LAUNCHES 1
#endif
constexpr int N_PHASES = 8;

constexpr size_t MiB = 1u << 20;
constexpr size_t WS_WIN = 2 * MiB, WS_WOUT = 6 * MiB, WS_WF1 = 8 * MiB, WS_WF2 = 16 * MiB, WS_WSP = 24 * MiB;
constexpr size_t WS_X1 = 32 * MiB;
constexpr size_t WS_XB = 160 * MiB;
constexpr size_t WS_PROJ = 288 * MiB;
constexpr size_t WS_MIX = 512 * MiB;
constexpr size_t WS_H = 512 * MiB;
constexpr size_t WS_END = 1024 * MiB;

typedef unsigned short bf16_t;
typedef short bf16x8 __attribute__((ext_vector_type(8)));
typedef short s16x4 __attribute__((ext_vector_type(4)));
typedef float f32x4 __attribute__((ext_vector_type(4)));
typedef float f32x16 __attribute__((ext_vector_type(16)));
typedef unsigned u32x4 __attribute__((ext_vector_type(4)));
typedef unsigned u32x2 __attribute__((ext_vector_type(2)));
#define LAS __attribute__((address_space(3)))
using pg8::cvtpk;
__device__ __forceinline__ float bflo(unsigned w) { return __uint_as_float(w << 16); }
__device__ __forceinline__ float bfhi(unsigned w) { return __uint_as_float(w & 0xffff0000u); }
__device__ __forceinline__ float wave_sum(float v) {
#pragma unroll
    for (int o = 1; o < 64; o <<= 1) v += __shfl_xor(v, o);
    return v;
}

__device__ __forceinline__ void p0_transpose_item(const float* W, int K, int N, bf16_t* WT, LAS float* scr, int item, int lane) {
    const int nblk = N / 32, kb = item / nblk, nb = item % nblk, k0 = 64 * kb, n0 = 32 * nb;
#pragma unroll 8
    for (int i = 0; i < 32; ++i) { const int kk = 2 * i + (lane >> 5); scr[kk * 33 + (lane & 31)] = W[(size_t)(k0 + kk) * N + n0 + (lane & 31)]; }
    asm volatile("s_waitcnt lgkmcnt(0)" ::: "memory");
    const int c = lane & 7;
#pragma unroll
    for (int j = 0; j < 4; ++j) { const int n = (lane >> 3) + 8 * j; const LAS float* s = scr + (8 * c) * 33 + n;
        u32x4 o; o.x = cvtpk(s[0 * 33], s[1 * 33]); o.y = cvtpk(s[2 * 33], s[3 * 33]); o.z = cvtpk(s[4 * 33], s[5 * 33]); o.w = cvtpk(s[6 * 33], s[7 * 33]);
        *(u32x4*)(WT + (size_t)(n0 + n) * K + k0 + 8 * c) = o; }
    asm volatile("s_waitcnt lgkmcnt(0)" ::: "memory");
}
__device__ __forceinline__ void row_to_bf16(const float* xrow, bf16_t* orow, int lane) {
    const f32x4* xr = (const f32x4*)xrow + lane; u32x2* o8 = (u32x2*)orow + lane;
    f32x4 v[4];
#pragma unroll
    for (int j = 0; j < 4; ++j) v[j] = xr[64 * j];
#pragma unroll
    for (int j = 0; j < 4; ++j) { u32x2 w; w.x = cvtpk(v[j].x, v[j].y); w.y = cvtpk(v[j].z, v[j].w); o8[64 * j] = w; }
}
__device__ __forceinline__ void ln_row(const float* xrow, const f32x4 (&g)[4], const f32x4 (&b)[4], bf16_t* oh, float* of, int lane) {
    const f32x4* xr = (const f32x4*)xrow + lane;
    f32x4 v[4]; float s = 0.f;
#pragma unroll
    for (int j = 0; j < 4; ++j) { v[j] = xr[64 * j]; s += (v[j].x + v[j].y) + (v[j].z + v[j].w); }
    const float mean = wave_sum(s) * (1.f / DM); float s2 = 0.f;
#pragma unroll
    for (int j = 0; j < 4; ++j) { v[j] = v[j] - mean; s2 += (v[j].x * v[j].x + v[j].y * v[j].y) + (v[j].z * v[j].z + v[j].w * v[j].w); }
    const float rstd = 1.f / sqrtf(wave_sum(s2) * (1.f / DM) + LN_EPS);
#pragma unroll
    for (int j = 0; j < 4; ++j) { const f32x4 o = v[j] * rstd * g[j] + b[j];
        if (oh) { u32x2 w; w.x = cvtpk(o.x, o.y); w.y = cvtpk(o.z, o.w); ((u32x2*)oh + lane)[64 * j] = w; }
        else ((f32x4*)of + lane)[64 * j] = o; }
}

namespace mix {
constexpr int KS = 144, VS = 192;
constexpr int OFF_K = 0, OFF_V = 384 * KS;
constexpr int VNS = 1088;
constexpr int OFF_SSQA = 128 * VNS;
constexpr int OFF_SSQ8 = OFF_SSQA + 1024;
static_assert(OFF_V + 384 * VS <= OFF_SSQA && OFF_SSQ8 + 4096 <= LDS_BYTES, "P2 LDS map");

__device__ __forceinline__ bf16x8 tr_frag(const LAS unsigned char* p0, const LAS unsigned char* p1) {
    const s16x4 lo = __builtin_bit_cast(s16x4, __builtin_amdgcn_ds_read_tr16_b64_v4i16((LAS s16x4*)p0));
    const s16x4 hi = __builtin_bit_cast(s16x4, __builtin_amdgcn_ds_read_tr16_b64_v4i16((LAS s16x4*)p1));
    return (bf16x8){lo[0], lo[1], lo[2], lo[3], hi[0], hi[1], hi[2], hi[3]};
}
#define MFMA32(a, b, c) __builtin_amdgcn_mfma_f32_32x32x16_bf16((a), (b), (c), 0, 0, 0)

__device__ __forceinline__ void kv_fetch(u32x4 (&pk)[6], u32x4 (&pv)[6], const bf16_t* __restrict__ proj, int b, int n, int g, int tid) {
#pragma unroll
    for (int i = 0; i < 6; ++i) { const int c = tid + NTHREADS * i, j = c >> 3, ch = c & 7, kpos = n * 128 - 128 + j;
        pk[i] = (u32x4){0u, 0u, 0u, 0u}; pv[i] = (u32x4){0u, 0u, 0u, 0u};
        if (kpos >= 0 && kpos < SEQ) { const bf16_t* src = proj + ((size_t)b * SEQ + kpos) * NIN + COL_K + g * 64 + ch * 8; pk[i] = *(const u32x4*)src; pv[i] = *(const u32x4*)(src + (COL_V - COL_K)); } }
}
__device__ __forceinline__ void kv_commit(LAS unsigned char* lds, const u32x4 (&pk)[6], const u32x4 (&pv)[6], int tid) {
#pragma unroll
    for (int i = 0; i < 6; ++i) { const int c = tid + NTHREADS * i, j = c >> 3, ch = c & 7;
        *(LAS u32x4*)(lds + OFF_K + j * KS + ch * 16) = pk[i]; *(LAS u32x4*)(lds + OFF_V + j * VS + ch * 16) = pv[i]; }
}
__device__ __forceinline__ void attn_unit(LAS unsigned char* lds, const bf16_t* __restrict__ proj, bf16_t* __restrict__ mixed, const float* __restrict__ sink, const float* __restrict__ ga, int b, int n) {
    int tid = threadIdx.x; asm volatile("" : "+v"(tid));
    const int lane = tid & 63, r32 = lane & 31, h = lane >> 5, wid = __builtin_amdgcn_readfirstlane(tid >> 6), qs = wid & 3, hp = wid >> 2;
    const size_t row0 = (size_t)b * SEQ + (size_t)n * 128;
    const int qrel = 32 * qs + r32;
    const bf16_t* qrow = proj + (row0 + qrel) * NIN;
    const int grp = lane >> 4, i16 = lane & 15, qq = i16 >> 2, pp = i16 & 3;
    const int vlane = (4 * h + qq) * VS + (16 * (grp & 1) + 4 * pp) * 2;
    const int klane = r32 * KS + h * 16;
    unsigned held[4][16]; float ssq = 0.f;
    u32x4 pk[6], pv[6];
    kv_fetch(pk, pv, proj, b, n, 0, tid);
    const int kt_lo = (n == 0) ? ((4 - qs) > 0 ? 4 - qs : 0) : 0;
    const int kt_hi = (n == SEQ / 128 - 1) ? ((8 - qs) < 9 ? 8 - qs : 9) : 9;
#pragma unroll
    for (int g = 0; g < 2; ++g) {
        bf16x8 qr[4];
#pragma unroll
        for (int d0 = 0; d0 < 4; ++d0) qr[d0] = *(const bf16x8*)(qrow + (4 * g + 2 * hp) * 64 + d0 * 16 + h * 8);
        __syncthreads();
        kv_commit(lds, pk, pv, tid);
        if (g == 0) kv_fetch(pk, pv, proj, b, n, 1, tid);
        __syncthreads();
#pragma unroll
        for (int hh = 0; hh < 2; ++hh) {
            const int head = 4 * g + 2 * hp + hh;
            if (hh == 1) {
#pragma unroll
                for (int d0 = 0; d0 < 4; ++d0) qr[d0] = *(const bf16x8*)(qrow + head * 64 + d0 * 16 + h * 8); }
            float m = sink[head] * LOG2E, l = (h == 0) ? 1.f : 0.f;
            f32x16 o0 = {}, o1 = {};
            const float slope2 = __builtin_amdgcn_exp2f(-(float)(head + 1)) * LOG2E;
            for (int kt = kt_lo; kt < kt_hi; ++kt) {
                const int j0 = 32 * (qs + kt);
                f32x16 p = {};
                const LAS unsigned char* kp = lds + OFF_K + j0 * KS + klane;
#pragma unroll
                for (int d0 = 0; d0 < 4; ++d0) { const bf16x8 kf = *(const LAS bf16x8*)(kp + d0 * 32); p = MFMA32(kf, qr[d0], p); }
                const float fb = (float)(qrel - (j0 + 4 * h - 128));
                float tm = -1e30f;
                if (kt == 0 || kt == 8) {
#pragma unroll
                    for (int r = 0; r < 16; ++r) { const float t = fb - (float)((r & 3) + 8 * (r >> 2)); float s = __builtin_fmaf(-slope2, __builtin_fabsf(t), p[r]);
                        s = (__builtin_fabsf(t) <= 128.f) ? s : -1e30f; p[r] = s; tm = fmaxf(tm, s); }
                } else {
#pragma unroll
                    for (int r = 0; r < 16; ++r) { const float t = fb - (float)((r & 3) + 8 * (r >> 2)); const float s = __builtin_fmaf(-slope2, __builtin_fabsf(t), p[r]); p[r] = s; tm = fmaxf(tm, s); }
                }
                tm = fmaxf(tm, __shfl_xor(tm, 32));
                if (__builtin_amdgcn_ballot_w64(tm > m)) {
                    const float mn = fmaxf(m, tm), f = __builtin_amdgcn_exp2f(m - mn); m = mn; l *= f;
#pragma unroll
                    for (int r = 0; r < 16; ++r) { o0[r] *= f; o1[r] *= f; }
                }
                float ls = 0.f;
#pragma unroll
                for (int r = 0; r < 16; ++r) { p[r] = __builtin_amdgcn_exp2f(p[r] - m); ls += p[r]; }
                l += ls;
                u32x4 w0, w1;
                w0.x = cvtpk(p[0], p[1]); w0.y = cvtpk(p[2], p[3]); w0.z = cvtpk(p[4], p[5]); w0.w = cvtpk(p[6], p[7]);
                w1.x = cvtpk(p[8], p[9]); w1.y = cvtpk(p[10], p[11]); w1.z = cvtpk(p[12], p[13]); w1.w = cvtpk(p[14], p[15]);
                const bf16x8 pb0 = __builtin_bit_cast(bf16x8, w0), pb1 = __builtin_bit_cast(bf16x8, w1);
                const LAS unsigned char* vp = lds + OFF_V + j0 * VS + vlane;
                o0 = MFMA32(tr_frag(vp, vp + 8 * VS), pb0, o0);
                o1 = MFMA32(tr_frag(vp + 64, vp + 8 * VS + 64), pb0, o1);
                o0 = MFMA32(tr_frag(vp + 16 * VS, vp + 24 * VS), pb1, o0);
                o1 = MFMA32(tr_frag(vp + 16 * VS + 64, vp + 24 * VS + 64), pb1, o1);
            }
            l += __shfl_xor(l, 32);
            const float inv = 1.f / l;
#pragma unroll
            for (int r = 0; r < 16; ++r) { o0[r] *= inv; o1[r] *= inv; ssq += o0[r] * o0[r] + o1[r] * o1[r]; }
#pragma unroll
            for (int r = 0; r < 8; ++r) { held[g * 2 + hh][r] = cvtpk(o0[2 * r], o0[2 * r + 1]); held[g * 2 + hh][8 + r] = cvtpk(o1[2 * r], o1[2 * r + 1]); }
        }
    }
    ssq += __shfl_xor(ssq, 32);
    LAS float* ssqA = (LAS float*)(lds + OFF_SSQA);
    if (h == 0) ssqA[hp * 128 + qrel] = ssq;
    __syncthreads();
    const float tot = ssqA[qrel] + ssqA[128 + qrel]; const float rstd = 1.f / sqrtf(tot * (1.f / 512.f) + LN_EPS);
    bf16_t* orow = mixed + (row0 + qrel) * DM;
#pragma unroll
    for (int x = 0; x < 4; ++x) { const int head = 4 * (x >> 1) + 2 * hp + (x & 1);
#pragma unroll
        for (int db = 0; db < 2; ++db)
#pragma unroll
            for (int rq = 0; rq < 4; ++rq) { const int d = head * 64 + 32 * db + 8 * rq + 4 * h; const f32x4 g4 = *(const f32x4*)(ga + d);
                const unsigned wa = held[x][db * 8 + 2 * rq], wb = held[x][db * 8 + 2 * rq + 1];
                u32x2 w; w.x = cvtpk(bflo(wa) * rstd * g4.x, bfhi(wa) * rstd * g4.y); w.y = cvtpk(bflo(wb) * rstd * g4.z, bfhi(wb) * rstd * g4.w);
                *(u32x2*)(orow + d) = w; } }
}

__device__ __forceinline__ void swap32(unsigned& a, unsigned& b) { auto rr = __builtin_amdgcn_permlane32_swap(a, b, false, false); a = rr[0]; b = rr[1]; }
__device__ __forceinline__ void sgu_compute(LAS unsigned char* lds, const bf16_t* __restrict__ proj, bf16_t* __restrict__ mixed, const bf16_t* __restrict__ wsf, const float* __restrict__ bsp, const float* __restrict__ gn, size_t row0) {
    int tid = threadIdx.x; asm volatile("" : "+v"(tid));
    const int lane = tid & 63, r32 = lane & 31, h = lane >> 5, g = __builtin_amdgcn_readfirstlane(tid >> 6);
    const int grp = lane >> 4, i16 = lane & 15, qq = i16 >> 2, pp = i16 & 3;
    const int vnlane = (8 * h + qq) * VNS + (64 * g + 16 * (grp & 1) + 4 * pp) * 2;
    LAS float* ssq8 = (LAS float*)(lds + OFF_SSQ8);
    unsigned hv[4][16];
    bf16x8 wf[8];
    const bf16_t* wbase = wsf + (size_t)g * 4 * 8 * 512 + lane * 8;
#pragma unroll
    for (int ks = 0; ks < 8; ++ks) wf[ks] = *(const bf16x8*)(wbase + ks * 512);
#pragma unroll
    for (int tb = 0; tb < 4; ++tb) {
        const int t = 32 * tb + r32;
        const bf16_t* gurow = proj + (row0 + t) * NIN + COL_U + 64 * g + 8 * h;
        u32x4 gl[4];
#pragma unroll
        for (int e = 0; e < 4; ++e) gl[e] = *(const u32x4*)(gurow + 16 * e);
        const float bs = bsp[g * 128 + t];
        bf16x8 wn[8];
        if (tb < 3) {
#pragma unroll
            for (int ks = 0; ks < 8; ++ks) wn[ks] = *(const bf16x8*)(wbase + ((tb + 1) * 8 + ks) * 512); }
        f32x16 a0 = {}, a1 = {};
#pragma unroll
        for (int ks = 0; ks < 8; ++ks) { const LAS unsigned char* vp = lds + ks * 16 * VNS + vnlane;
            a0 = MFMA32(tr_frag(vp, vp + 4 * VNS), wf[ks], a0); a1 = MFMA32(tr_frag(vp + 64, vp + 4 * VNS + 64), wf[ks], a1); }
        float ss = 0.f;
#pragma unroll
        for (int e = 0; e < 4; ++e) {
            unsigned x0 = gl[e].x, x1 = gl[e].y, y0 = gl[e].z, y1 = gl[e].w;
            swap32(x0, y0); swap32(x1, y1);
            const f32x16& a = (e >> 1) ? a1 : a0; const int rq = 2 * (e & 1);
            const float v0 = bflo(x0) * (a[4 * rq + 0] + bs), v1 = bfhi(x0) * (a[4 * rq + 1] + bs), v2 = bflo(x1) * (a[4 * rq + 2] + bs), v3 = bfhi(x1) * (a[4 * rq + 3] + bs);
            const float v4 = bflo(y0) * (a[4 * rq + 4] + bs), v5 = bfhi(y0) * (a[4 * rq + 5] + bs), v6 = bflo(y1) * (a[4 * rq + 6] + bs), v7 = bfhi(y1) * (a[4 * rq + 7] + bs);
            ss += ((v0 * v0 + v1 * v1) + (v2 * v2 + v3 * v3)) + ((v4 * v4 + v5 * v5) + (v6 * v6 + v7 * v7));
            hv[tb][4 * e + 0] = cvtpk(v0, v1); hv[tb][4 * e + 1] = cvtpk(v2, v3); hv[tb][4 * e + 2] = cvtpk(v4, v5); hv[tb][4 * e + 3] = cvtpk(v6, v7); }
        ss += __shfl_xor(ss, 32); if (h == 0) ssq8[g * 128 + t] = ss;
        if (tb < 3) {
#pragma unroll
            for (int ks = 0; ks < 8; ++ks) wf[ks] = wn[ks]; }
    }
    __syncthreads();
#pragma unroll
    for (int tb = 0; tb < 4; ++tb) {
        const int t = 32 * tb + r32;
        float tot = 0.f;
#pragma unroll
        for (int gg = 0; gg < 8; ++gg) tot += ssq8[gg * 128 + t];
        const float rstd = 1.f / sqrtf(tot * (1.f / 512.f) + LN_EPS);
        bf16_t* orow = mixed + (row0 + t) * DM + 512 + 64 * g + 8 * h;
#pragma unroll
        for (int e = 0; e < 4; ++e) { const int db = e >> 1, rq = 2 * (e & 1);
            const f32x4 ge = *(const f32x4*)(gn + 64 * g + 32 * db + 8 * rq + 4 * h), go = *(const f32x4*)(gn + 64 * g + 32 * db + 8 * rq + 8 + 4 * h);
            const unsigned w0 = hv[tb][4 * e + 0], w1 = hv[tb][4 * e + 1], w2 = hv[tb][4 * e + 2], w3 = hv[tb][4 * e + 3];
            unsigned x0 = cvtpk(bflo(w0) * rstd * ge.x, bfhi(w0) * rstd * ge.y), x1 = cvtpk(bflo(w1) * rstd * ge.z, bfhi(w1) * rstd * ge.w);
            unsigned y0 = cvtpk(bflo(w2) * rstd * go.x, bfhi(w2) * rstd * go.y), y1 = cvtpk(bflo(w3) * rstd * go.z, bfhi(w3) * rstd * go.w);
            swap32(x0, y0); swap32(x1, y1);
            *(u32x4*)(orow + 16 * e) = (u32x4){x0, x1, y0, y1}; }
    }
}
__device__ __forceinline__ void sgu_unit(LAS unsigned char* lds, const bf16_t* __restrict__ proj, bf16_t* __restrict__ mixed, const float* __restrict__ lng, const float* __restrict__ lnb,
                                         const bf16_t* __restrict__ wsb, const float* __restrict__ bsp, const float* __restrict__ gn, int b, int n) {
    int tid = threadIdx.x; asm volatile("" : "+v"(tid));
    const int lane = tid & 63, wid = __builtin_amdgcn_readfirstlane(tid >> 6);
    const size_t row0 = (size_t)b * SEQ + (size_t)n * 128;
    const f32x4 ga = *(const f32x4*)(lng + lane * 8), gb = *(const f32x4*)(lng + lane * 8 + 4), ba = *(const f32x4*)(lnb + lane * 8), bb = *(const f32x4*)(lnb + lane * 8 + 4);
    u32x4 vw[8];
#pragma unroll
    for (int i = 0; i < 8; ++i) vw[i] = *(const u32x4*)(proj + (row0 + wid * 16 + i) * NIN + COL_VG + lane * 8);
    __syncthreads();
#pragma unroll
    for (int hb = 0; hb < 2; ++hb) {
        u32x4 vc[8];
#pragma unroll
        for (int i = 0; i < 8; ++i) vc[i] = vw[i];
        if (hb == 0) {
#pragma unroll
            for (int i = 0; i < 8; ++i) vw[i] = *(const u32x4*)(proj + (row0 + wid * 16 + 8 + i) * NIN + COL_VG + lane * 8); }
#pragma unroll
        for (int i = 0; i < 8; ++i) { const int t = wid * 16 + hb * 8 + i; const u32x4 w = vc[i];
            float v[8] = {bflo(w.x), bfhi(w.x), bflo(w.y), bfhi(w.y), bflo(w.z), bfhi(w.z), bflo(w.w), bfhi(w.w)};
            float s = 0.f;
#pragma unroll
            for (int k = 0; k < 8; ++k) s += v[k];
            const float mean = wave_sum(s) * (1.f / 512.f); float s2 = 0.f;
#pragma unroll
            for (int k = 0; k < 8; ++k) { v[k] -= mean; s2 += v[k] * v[k]; }
            const float rstd = 1.f / sqrtf(wave_sum(s2) * (1.f / 512.f) + LN_EPS);
            u32x4 o; o.x = cvtpk(v[0] * rstd * ga.x + ba.x, v[1] * rstd * ga.y + ba.y); o.y = cvtpk(v[2] * rstd * ga.z + ba.z, v[3] * rstd * ga.w + ba.w);
            o.z = cvtpk(v[4] * rstd * gb.x + bb.x, v[5] * rstd * gb.y + bb.y); o.w = cvtpk(v[6] * rstd * gb.z + bb.z, v[7] * rstd * gb.w + bb.w);
            *(LAS u32x4*)(lds + t * VNS + lane * 16) = o; }
    }
    __syncthreads();
    sgu_compute(lds, proj, mixed, wsb, bsp, gn, row0);
}
}

struct Args { const float* in[16]; float* out; unsigned char* ws; int ph_lo, ph_hi; };
__global__ void __launch_bounds__(NTHREADS, 2) fwd_kernel(Args args) {
    extern __shared__ __attribute__((aligned(16))) unsigned char lds_raw[];
    LAS unsigned char* lds = (LAS unsigned char*)lds_raw;
    cg::grid_group grid = cg::this_grid();
    int tid = threadIdx.x; asm volatile("" : "+v"(tid));
    const int lane = tid & 63, wave = __builtin_amdgcn_readfirstlane(tid >> 6);
    const int G = gridDim.x, bx = blockIdx.x;
    const int vcu = (G % 8 == 0) ? (bx % 8) * (G / 8) + bx / 8 : bx;
    const int gw = vcu * NWAVES + wave, NGW = G * NWAVES;
    unsigned char* ws = args.ws;
    const float* x = args.in[0]; const float* w_in = args.in[1]; const float* sink = args.in[2]; const float* lng = args.in[3]; const float* lnb = args.in[4];
    const float* w_sp = args.in[5]; const float* b_sp = args.in[6]; const float* ga = args.in[7]; const float* gn = args.in[8]; const float* w_out = args.in[9];
    const float* ln1g = args.in[10]; const float* ln1b = args.in[11]; const float* w_f1 = args.in[12]; const float* w_f2 = args.in[13]; const float* ln2g = args.in[14]; const float* ln2b = args.in[15];
    bf16_t* WIN = (bf16_t*)(ws + WS_WIN); bf16_t* WOUT = (bf16_t*)(ws + WS_WOUT); bf16_t* WF1 = (bf16_t*)(ws + WS_WF1); bf16_t* WF2 = (bf16_t*)(ws + WS_WF2); bf16_t* WSP = (bf16_t*)(ws + WS_WSP);
    bf16_t* X1 = (bf16_t*)(ws + WS_X1); bf16_t* XB = (bf16_t*)(ws + WS_XB); bf16_t* PROJ = (bf16_t*)(ws + WS_PROJ); bf16_t* MIX = (bf16_t*)(ws + WS_MIX); bf16_t* HB = (bf16_t*)(ws + WS_H);
    float* out = args.out;
    const int lo = args.ph_lo, hi = args.ph_hi;
#define IN(k) (lo <= (k) && (k) < hi)
#define SEAM(k) do { if (IN(k) && IN((k) + 1)) grid.sync(); } while (0)
#ifndef PROBE_PHASE
#define PROBE_PHASE -1
#endif
#define REPS(k) for (int rep_ = 0; rep_ < ((k) == PROBE_PHASE ? 2 : 1); ++rep_, ((k) == PROBE_PHASE && rep_ == 1 ? grid.sync() : (void)0))

    REPS(0) if (IN(0)) {
        LAS float* scr = (LAS float*)(lds + wave * 16384);
        constexpr int I_IN = (DM / 64) * (NIN / 32), I_OUT = (DM / 64) * (DM / 32), I_F1 = (DM / 64) * (FF / 32), I_F2 = (FF / 64) * (DM / 32), I_SP = 8 * 128 * 128 / 512;
        constexpr int NITEMS = I_IN + I_OUT + I_F1 + I_F2 + I_SP;
        for (int it = gw; it < NITEMS; it += NGW) {
            int r = it;
            if (r < I_IN) { p0_transpose_item(w_in, DM, NIN, WIN, scr, r, lane); continue; } r -= I_IN;
            if (r < I_OUT) { p0_transpose_item(w_out, DM, DM, WOUT, scr, r, lane); continue; } r -= I_OUT;
            if (r < I_F1) { p0_transpose_item(w_f1, DM, FF, WF1, scr, r, lane); continue; } r -= I_F1;
            if (r < I_F2) { p0_transpose_item(w_f2, FF, DM, WF2, scr, r, lane); continue; } r -= I_F2;
            { const int sg = r >> 5, stb = (r >> 3) & 3, sks = r & 7;
              const float* src = w_sp + ((size_t)(sg * 128 + 32 * stb + (lane & 31))) * 128 + 16 * sks + 8 * (lane >> 5); const f32x4 a = *(const f32x4*)src, b = *(const f32x4*)(src + 4);
              u32x4 o; o.x = cvtpk(a.x, a.y); o.y = cvtpk(a.z, a.w); o.z = cvtpk(b.x, b.y); o.w = cvtpk(b.z, b.w); *(u32x4*)(WSP + (size_t)r * 512 + lane * 8) = o; }
        }
        for (int m = gw; m < MROWS; m += NGW) row_to_bf16(x + (size_t)m * DM, XB + (size_t)m * DM, lane);
    }
    SEAM(0);
    REPS(1) if (IN(1)) {
        pg8::Gemm g{XB, WIN, MROWS, NIN, DM}; pg8::StaticOrder S; S.init(MROWS, NIN, G, bx);
        pg8::EpiAct E{PROJ, NIN, 0, QSCALE};
        pg8::gemm_phase<pg8::EpiAct, pg8::StaticOrder, true, true>(lds, g, S, E);
    }
    SEAM(1);
    REPS(2) if (IN(2)) {
        constexpr int NU = BATCH * (SEQ / 128);
        const int per = (NU + G - 1) / G;
        for (int i = 0; i < per; ++i) { const int u = vcu * per + i; if (u >= NU) break;
            const int b = u / (SEQ / 128), n = u % (SEQ / 128);
#ifndef PROBE_P2
#define PROBE_P2 0
#endif
            for (int rp = 0; rp < (PROBE_P2 == 1 ? 2 : 1); ++rp) mix::attn_unit(lds, PROJ, MIX, sink, ga, b, n);
            for (int rp = 0; rp < (PROBE_P2 == 2 ? 2 : 1); ++rp) mix::sgu_unit(lds, PROJ, MIX, lng, lnb, WSP, b_sp, gn, b, n); }
    }
    SEAM(2);
    REPS(3) if (IN(3)) {
        pg8::Gemm g{MIX, WOUT, MROWS, DM, DM}; pg8::StaticOrder S; S.init(MROWS, DM, G, bx);
        pg8::EpiRes E{x, nullptr, out, DM, ALPHA};
        pg8::gemm_phase<pg8::EpiRes, pg8::StaticOrder, true, true>(lds, g, S, E);
    }
    SEAM(3);
    REPS(4) if (IN(4)) {
        f32x4 g4[4], b4[4];
#pragma unroll
        for (int j = 0; j < 4; ++j) { g4[j] = ((const f32x4*)ln1g + lane)[64 * j]; b4[j] = ((const f32x4*)ln1b + lane)[64 * j]; }
        for (int m = gw; m < MROWS; m += NGW) ln_row(out + (size_t)m * DM, g4, b4, X1 + (size_t)m * DM, nullptr, lane);
    }
    SEAM(4);
    REPS(5) if (IN(5)) {
        pg8::Gemm g{X1, WF1, MROWS, FF, DM}; pg8::StaticOrder S; S.init(MROWS, FF, G, bx);
        pg8::EpiAct E{HB, FF, 1, 1.f};
        pg8::gemm_phase<pg8::EpiAct, pg8::StaticOrder, true, true>(lds, g, S, E);
    }
    SEAM(5);
    REPS(6) if (IN(6)) {
        pg8::Gemm g{HB, WF2, MROWS, DM, FF}; pg8::StaticOrder S; S.init(MROWS, DM, G, bx);
        pg8::EpiRes E{nullptr, X1, out, DM, ALPHA};
        pg8::gemm_phase<pg8::EpiRes, pg8::StaticOrder, true, true>(lds, g, S, E);
    }
    SEAM(6);
    REPS(7) if (IN(7)) {
        f32x4 g4[4], b4[4];
#pragma unroll
        for (int j = 0; j < 4; ++j) { g4[j] = ((const f32x4*)ln2g + lane)[64 * j]; b4[j] = ((const f32x4*)ln2b + lane)[64 * j]; }
        for (int m = gw; m < MROWS; m += NGW) ln_row(out + (size_t)m * DM, g4, b4, nullptr, out + (size_t)m * DM, lane);
    }
#undef IN
#undef SEAM
}

extern "C" void kernel_launch(void* const* d_in, const int* in_sizes, int n_in, void* d_out, int out_size, void* d_ws, size_t ws_size, hipStream_t stream) {
    static int grid = 0;
    if (grid == 0) {
        if (n_in != 16 || in_sizes[0] != MROWS * DM || out_size != MROWS * DM || ws_size < WS_END) {
            fprintf(stderr, "kernel_launch: unexpected shapes (n_in %d, in0 %d, out %d, ws %zu); nothing launched\n", n_in, n_in > 0 ? in_sizes[0] : -1, out_size, ws_size); grid = -1; return; }
        int dev = 0, cus = 0, per_cu = 0;
        if (hipGetDevice(&dev) != hipSuccess || hipDeviceGetAttribute(&cus, hipDeviceAttributeMultiprocessorCount, dev) != hipSuccess) { grid = -1; return; }
        if (hipFuncSetAttribute((const void*)fwd_kernel, hipFuncAttributeMaxDynamicSharedMemorySize, LDS_BYTES) != hipSuccess) { fprintf(stderr, "kernel_launch: hipFuncSetAttribute failed\n"); grid = -1; return; }
        if (hipOccupancyMaxActiveBlocksPerMultiprocessor(&per_cu, (const void*)fwd_kernel, NTHREADS, LDS_BYTES) != hipSuccess || per_cu < 1) { fprintf(stderr, "kernel_launch: occupancy query says %d blocks per CU\n", per_cu); per_cu = 1; }
        (void)hipGetLastError();
        grid = cus * per_cu;
    }
    if (grid < 0) return;
    Args a{};
    for (int i = 0; i < 16; ++i) a.in[i] = (const float*)d_in[i];
    a.out = (float*)d_out; a.ws = (unsigned char*)d_ws;
    if (MK_N_LAUNCHES == 1) {
        a.ph_lo = 0; a.ph_hi = N_PHASES;
        void* kargs[] = {&a};
        const hipError_t e = hipLaunchCooperativeKernel((const void*)fwd_kernel, dim3(grid), dim3(NTHREADS), kargs, LDS_BYTES, stream);
        if (e != hipSuccess) fprintf(stderr, "kernel_launch: cooperative launch failed: %s (grid %d)\n", hipGetErrorString(e), grid);
    } else {
        for (int k = 0; k < N_PHASES; ++k) { a.ph_lo = k; a.ph_hi = k + 1;
            hipLaunchKernelGGL(fwd_kernel, dim3(grid), dim3(NTHREADS), LDS_BYTES, stream, a); }
    }
}
```

```cpp
#include <hip/hip_runtime.h>
#include <hip/hip_cooperative_groups.h>
#include <cstdio>
#include <cstdint>
namespace cg = cooperative_groups;
#define MK_N_LAUNCHES 1
namespace pg8 {
#define PG8_LAS __attribute__((address_space(3)))
typedef unsigned short bf16_t;
typedef short bf16x8 __attribute__((ext_vector_type(8)));
typedef float f32x4 __attribute__((ext_vector_type(4)));
typedef unsigned u32x4 __attribute__((ext_vector_type(4)));
constexpr int BM = 256, BK = 64, HALF = 128, HTB = HALF * BK * 2  , STAGE_BYTES = 8 * HTB, NXCD = 8, WGM = 8;

__host__ __device__ __forceinline__ int lds_byte(int r, int c) { const int st = (r >> 4) * 2 + (c >> 5), rr = r & 15, cc = c & 31, ob = rr * 64 + cc * 2; return st * 1024 + (ob ^ (((ob >> 9) & 1) << 5)); }
__host__ __device__ __forceinline__ void stage_rc(int b, int& R, int& C) { const int st = b / 1024, sb = b % 1024, swz = sb ^ (((sb >> 9) & 1) << 5); R = (st >> 1) * 16 + swz / 64; C = (st & 1) * 32 + (swz % 64) / 2; }
__host__ __device__ __forceinline__ int perm32(int rho) { const int n = rho >> 4, i = rho & 15; return 8 * (i >> 2) + 4 * n + (i & 3); }

struct Unit { int pm, pn; };
struct Gemm { const bf16_t* A; const bf16_t* Bt; int M, N, K; };

struct StaticOrder {
    int nM, nN, nwg, G, c;
    __host__ __device__ void init(int M, int N, int G_, int c_) { nM = M / BM; nN = N / BM; nwg = nM * nN; G = G_; c = c_; }
    __host__ __device__ bool next(int i, Unit& u) const {
        const long L = (long)i * G + c; if (L >= nwg) return false;
        int wgid = (int)L; { const int q = nwg / NXCD, r = nwg % NXCD, xcd = wgid % NXCD, off = wgid / NXCD; wgid = (xcd < r ? xcd * (q + 1) : r * (q + 1) + (xcd - r) * q) + off; }
        const int nig = WGM * nN, gid = wgid / nig, fm = gid * WGM, gsz = (nM - fm) < WGM ? (nM - fm) : WGM;
        u.pm = fm + ((wgid % nig) % gsz); u.pn = (wgid % nig) / gsz; return true;
    }
    __device__ __forceinline__ void a_ready(const Unit&) const {}
    __device__ __forceinline__ void done(const Unit&) const {}
};

__device__ __forceinline__ unsigned cvt_pk_bf16(float lo, float hi) { unsigned r; asm volatile("v_cvt_pk_bf16_f32 %0, %1, %2" : "=v"(r) : "v"(lo), "v"(hi)); return r; }
typedef float f32x2 __attribute__((ext_vector_type(2)));
__device__ __forceinline__ f32x2 gelu_pk(f32x2 v) {
    const f32x2 av = __builtin_elementwise_abs(v), d = av * 0.2316418882f + 1.0f;
    f32x2 t; t.x = __builtin_amdgcn_rcpf(d.x); t.y = __builtin_amdgcn_rcpf(d.y);
    f32x2 q = t * 0.5307027145f + (-0.7265760135f); q = q * t + 0.7107068705f; q = q * t + (-0.142248368f); q = q * t + 0.127414796f; q = q * t;
    const f32x2 s = (v * v) * (-0.72134752044f);
    f32x2 e; e.x = __builtin_amdgcn_exp2f(s.x); e.y = __builtin_amdgcn_exp2f(s.y);
    const f32x2 m = v * (q * e), r = v - m;
    f32x2 o; o.x = v.x < 0.f ? m.x : r.x; o.y = v.y < 0.f ? m.y : r.y; return o;
}
typedef unsigned u32x2 __attribute__((ext_vector_type(2)));
typedef __bf16 bf16x2_t __attribute__((ext_vector_type(2)));
__device__ __forceinline__ unsigned cvtpk(float lo, float hi) { f32x2 v = {lo, hi}; bf16x2_t b = __builtin_convertvector(v, bf16x2_t); return __builtin_bit_cast(unsigned, b); }
struct EpiAct {
    static constexpr bool PERM = true, AFTER_DRAIN = false;
    bf16_t* O; int ldc; int mode; float q_scale;
    __device__ __forceinline__ void operator()(const f32x4 (&acc)[2][2][4][2], const Unit& u, int wr, int wc, int fr, int fq) const {
        const int row0 = u.pm * BM + wr * 64 + fr; const int col0 = u.pn * BM + wc * 32 + 8 * fq;
        int act = 2; float sc = 1.f;
        if (mode == 0) { act = (u.pn >= 3) ? 1 : 0; sc = (u.pn < 2) ? q_scale : 1.f; }
#pragma unroll
        for (int ai = 0; ai < 2; ++ai)
#pragma unroll
            for (int m = 0; m < 4; ++m) { bf16_t* rowp = O + (size_t)(row0 + ai * HALF + m * 16) * ldc + col0;
#pragma unroll
                for (int bj = 0; bj < 2; ++bj) { f32x4 v0 = acc[ai][bj][m][0], v1 = acc[ai][bj][m][1];
                    if (act == 1) { f32x2 a = gelu_pk((f32x2){v0[0], v0[1]}), b = gelu_pk((f32x2){v0[2], v0[3]}), c = gelu_pk((f32x2){v1[0], v1[1]}), d = gelu_pk((f32x2){v1[2], v1[3]});
                        v0 = (f32x4){a.x, a.y, b.x, b.y}; v1 = (f32x4){c.x, c.y, d.x, d.y}; }
                    else if (act == 2) {
#pragma unroll
                        for (int k = 0; k < 4; ++k) { const float a = fmaxf(v0[k], 0.f), b = fmaxf(v1[k], 0.f); v0[k] = a * a; v1[k] = b * b; } }
                    else { v0 = v0 * sc; v1 = v1 * sc; }
                    u32x4 w; w.x = cvtpk(v0[0], v0[1]); w.y = cvtpk(v0[2], v0[3]); w.z = cvtpk(v1[0], v1[1]); w.w = cvtpk(v1[2], v1[3]);
                    *(u32x4*)(rowp + bj * HALF) = w; } }
    }
};
struct EpiRes {
    static constexpr bool PERM = false, AFTER_DRAIN = false;
    const float* basef; const bf16_t* baseh; float* out; int ldc; float alpha;
    __device__ __forceinline__ void operator()(const f32x4 (&acc)[2][2][4][2], const Unit& u, int wr, int wc, int fr, int fq) const {
        const int row0 = u.pm * BM + wr * 64 + fr; const int col0 = u.pn * BM + wc * 32 + 4 * fq;
#pragma unroll
        for (int ai = 0; ai < 2; ++ai)
#pragma unroll
            for (int m = 0; m < 4; ++m) { const size_t off = (size_t)(row0 + ai * HALF + m * 16) * ldc + col0;
#pragma unroll
                for (int bj = 0; bj < 2; ++bj)
#pragma unroll
                    for (int n = 0; n < 2; ++n) { const size_t c = off + bj * HALF + n * 16; f32x4 bs;
                        if (basef) bs = *(const f32x4*)(basef + c);
                        else { const u32x2 w = *(const u32x2*)(baseh + c); bs = (f32x4){__uint_as_float(w.x << 16), __uint_as_float(w.x & 0xffff0000u), __uint_as_float(w.y << 16), __uint_as_float(w.y & 0xffff0000u)}; }
                        *(f32x4*)(out + c) = bs * alpha + acc[ai][bj][m][n]; }
                asm volatile("" ::: "memory"); }
    }
};
struct EpiLnStat {
    static constexpr bool PERM = false, AFTER_DRAIN = false;
    const float* basef; bf16_t* V; float* stats; int ldc; float alpha; PG8_LAS unsigned char* xl;
    __device__ __forceinline__ void operator()(const f32x4 (&acc)[2][2][4][2], const Unit& u, int wr, int wc, int fr, int fq) const {
        PG8_LAS f32x2* P = (PG8_LAS f32x2*)xl;
        const int row0 = u.pm * BM + wr * 64 + fr; const int col0 = u.pn * BM + wc * 32 + 4 * fq;
#pragma unroll
        for (int ai = 0; ai < 2; ++ai)
#pragma unroll
            for (int m = 0; m < 4; ++m) { const size_t off = (size_t)(row0 + ai * HALF + m * 16) * ldc + col0; float s = 0.f, q = 0.f;
#pragma unroll
                for (int bj = 0; bj < 2; ++bj)
#pragma unroll
                    for (int n = 0; n < 2; ++n) { const size_t c = off + bj * HALF + n * 16; const f32x4 bs = *(const f32x4*)(basef + c); const f32x4 v = bs * alpha + acc[ai][bj][m][n];
                        s += (v[0] + v[1]) + (v[2] + v[3]); q += (v[0] * v[0] + v[1] * v[1]) + (v[2] * v[2] + v[3] * v[3]);
                        u32x2 w; w.x = cvtpk(v[0], v[1]); w.y = cvtpk(v[2], v[3]); *(u32x2*)(V + c) = w; }
                s += __shfl_xor(s, 16); s += __shfl_xor(s, 32); q += __shfl_xor(q, 16); q += __shfl_xor(q, 32);
                if (fq == 0) P[(ai * HALF + wr * 64 + m * 16 + fr) * 4 + wc] = (f32x2){s, q};
                asm volatile("" ::: "memory"); }
        asm volatile("s_waitcnt lgkmcnt(0)" ::: "memory"); __builtin_amdgcn_s_barrier(); asm volatile("" ::: "memory");
        const int tid = threadIdx.x;
        if (tid < BM) { const f32x2 a = P[tid * 4 + 0], b = P[tid * 4 + 1], c = P[tid * 4 + 2], d = P[tid * 4 + 3];
            *(f32x2*)(stats + ((size_t)(u.pm * BM + tid) * 4 + u.pn) * 2) = (f32x2){(a.x + b.x) + (c.x + d.x), (a.y + b.y) + (c.y + d.y)}; }
    }
};
__device__ __forceinline__ void row_stats(const float* stats, int row, float eps, float& rstd, float& rm) {
    const f32x4 s0 = *(const f32x4*)(stats + (size_t)row * 8), s1 = *(const f32x4*)(stats + (size_t)row * 8 + 4);
    const float S = (s0[0] + s0[2]) + (s1[0] + s1[2]), Q = (s0[1] + s0[3]) + (s1[1] + s1[3]);
    const float mean = S * (1.f / 1024.f), var = fmaxf(Q * (1.f / 1024.f) - mean * mean, 0.f);
    rstd = 1.f / sqrtf(var + eps); rm = rstd * mean;
}
struct EpiFfUp {
    static constexpr bool PERM = true, AFTER_DRAIN = false;
    bf16_t* O; int ldc; const float* stats; const float* cg; const float* cb; float eps;
    __device__ __forceinline__ void operator()(const f32x4 (&acc)[2][2][4][2], const Unit& u, int wr, int wc, int fr, int fq) const {
        const int row0 = u.pm * BM + wr * 64 + fr; const int col0 = u.pn * BM + wc * 32 + 8 * fq;
        f32x4 cgv[2][2], cbv[2][2];
#pragma unroll
        for (int bj = 0; bj < 2; ++bj)
#pragma unroll
            for (int n = 0; n < 2; ++n) { cgv[bj][n] = *(const f32x4*)(cg + col0 + bj * HALF + 4 * n); cbv[bj][n] = *(const f32x4*)(cb + col0 + bj * HALF + 4 * n); }
#pragma unroll
        for (int ai = 0; ai < 2; ++ai)
#pragma unroll
            for (int m = 0; m < 4; ++m) { const int row = row0 + ai * HALF + m * 16; float rstd, rm; row_stats(stats, row, eps, rstd, rm);
                bf16_t* rowp = O + (size_t)row * ldc + col0;
#pragma unroll
                for (int bj = 0; bj < 2; ++bj) { f32x4 v0 = acc[ai][bj][m][0] * rstd + (cbv[bj][0] - cgv[bj][0] * rm), v1 = acc[ai][bj][m][1] * rstd + (cbv[bj][1] - cgv[bj][1] * rm);
#pragma unroll
                    for (int k = 0; k < 4; ++k) { const float a = fmaxf(v0[k], 0.f), b = fmaxf(v1[k], 0.f); v0[k] = a * a; v1[k] = b * b; }
                    u32x4 w; w.x = cvtpk(v0[0], v0[1]); w.y = cvtpk(v0[2], v0[3]); w.z = cvtpk(v1[0], v1[1]); w.w = cvtpk(v1[2], v1[3]);
                    *(u32x4*)(rowp + bj * HALF) = w; } }
    }
};
struct EpiFfDown {
    static constexpr bool PERM = false, AFTER_DRAIN = false;
    const bf16_t* V; const float* stats; const float* g; const float* b; float* out; int ldc; float alpha, eps;
    __device__ __forceinline__ void operator()(const f32x4 (&acc)[2][2][4][2], const Unit& u, int wr, int wc, int fr, int fq) const {
        const int row0 = u.pm * BM + wr * 64 + fr; const int col0 = u.pn * BM + wc * 32 + 4 * fq;
        f32x4 gv[2][2], bv[2][2];
#pragma unroll
        for (int bj = 0; bj < 2; ++bj)
#pragma unroll
            for (int n = 0; n < 2; ++n) { gv[bj][n] = *(const f32x4*)(g + col0 + bj * HALF + n * 16) * alpha; bv[bj][n] = *(const f32x4*)(b + col0 + bj * HALF + n * 16) * alpha; }
#pragma unroll
        for (int ai = 0; ai < 2; ++ai)
#pragma unroll
            for (int m = 0; m < 4; ++m) { const int row = row0 + ai * HALF + m * 16; float rstd, rm; row_stats(stats, row, eps, rstd, rm);
                const size_t off = (size_t)row * ldc + col0;
#pragma unroll
                for (int bj = 0; bj < 2; ++bj)
#pragma unroll
                    for (int n = 0; n < 2; ++n) { const size_t c = off + bj * HALF + n * 16; const u32x2 w = *(const u32x2*)(V + c);
                        const f32x4 vv = (f32x4){__uint_as_float(w.x << 16), __uint_as_float(w.x & 0xffff0000u), __uint_as_float(w.y << 16), __uint_as_float(w.y & 0xffff0000u)};
                        *(f32x4*)(out + c) = (vv * rstd - rm) * gv[bj][n] + bv[bj][n] + acc[ai][bj][m][n]; }
                asm volatile("" ::: "memory"); }
    }
};
template <class Epi, class Sched, bool ALIGN_EPI = false, bool SP2 = false>
__device__ __forceinline__ void gemm_phase(PG8_LAS unsigned char* lds, const Gemm g, const Sched& S, const Epi& E) {
    const int tid = threadIdx.x, wid = __builtin_amdgcn_readfirstlane(tid >> 6), lane = tid & 63, wr = wid >> 2, wc = wid & 3, fr = lane & 15, fq = lane >> 4;
    const int K = g.K, nt = K / BK;
    unsigned voffA[2], voffB[2];
#pragma unroll
    for (int i = 0; i < 2; ++i) { int R, C; stage_rc(tid * 16 + i * 8192, R, C); const int Rb = Epi::PERM ? ((R & ~31) + perm32(R & 31)) : R;
        voffA[i] = (unsigned)(R * K + C) * 2u; voffB[i] = (unsigned)(Rb * K + C) * 2u; }
    const size_t kstep = (size_t)(BK * 2);
    const size_t hstep = (size_t)HALF * K * 2;
    const size_t tstep = 2 * hstep;
    const unsigned ldsw = (unsigned)wid * 1024u;
    const int aoff = lds_byte(wr * 64 + fr, fq * 8), boff = lds_byte(wc * 32 + fr, fq * 8);
#define PG8_SA(b, h) (((b) * 2 + (h)) * HTB)
#define PG8_SB(b, h) ((4 + (b) * 2 + (h)) * HTB)
#define PG8_STAGE(bufoff, gbase, voff) do { _Pragma("unroll") for (int _i = 0; _i < 2; ++_i) \
        __builtin_amdgcn_global_load_lds((const unsigned*)((const char*)(gbase) + (voff)[_i]), (PG8_LAS unsigned*)(lds + (bufoff) + ldsw + _i * 8192), 16, 0, 0); } while (0)
#define PG8_LDA(dst, b, h) do { _Pragma("unroll") for (int m = 0; m < 4; ++m) _Pragma("unroll") for (int k = 0; k < 2; ++k) dst[m][k] = *(const PG8_LAS bf16x8*)(lds + PG8_SA(b, h) + aoff + m * 2048 + k * 1024); } while (0)
#define PG8_LDB(dst, b, h) do { _Pragma("unroll") for (int n = 0; n < 2; ++n) _Pragma("unroll") for (int k = 0; k < 2; ++k) dst[n][k] = *(const PG8_LAS bf16x8*)(lds + PG8_SB(b, h) + boff + n * 2048 + k * 1024); } while (0)
#define PG8_MMA(ai, bj, At, Bt) do { __builtin_amdgcn_s_setprio(1); _Pragma("unroll") for (int m = 0; m < 4; ++m) _Pragma("unroll") for (int n = 0; n < 2; ++n) _Pragma("unroll") for (int k = 0; k < 2; ++k) \
        acc[ai][bj][m][n] = __builtin_amdgcn_mfma_f32_16x16x32_bf16(Bt[n][k], At[m][k], acc[ai][bj][m][n], 0, 0, 0); __builtin_amdgcn_s_setprio(0); } while (0)
#define PG8_WAIT_V(n) asm volatile("s_waitcnt vmcnt(" #n ")" ::: "memory")
#define PG8_WAIT_L(n) asm volatile("s_waitcnt lgkmcnt(" #n ")" ::: "memory")
#define PG8_BAR __builtin_amdgcn_s_barrier()
#define PG8_SCHED __builtin_amdgcn_sched_barrier(0)
    Unit cur, nxt; int ui = 0;
    if (!S.next(0, cur)) return;
    f32x4 acc[2][2][4][2];
#pragma unroll
    for (int a = 0; a < 2; ++a)
#pragma unroll
        for (int b = 0; b < 2; ++b)
#pragma unroll
            for (int m = 0; m < 4; ++m)
#pragma unroll
                for (int n = 0; n < 2; ++n) acc[a][b][m][n] = (f32x4){0.f, 0.f, 0.f, 0.f};
    bf16x8 At[4][2], B0[2][2], B1[2][2];
    const char* cA = (const char*)g.A + (size_t)cur.pm * tstep; const char* cB = (const char*)g.Bt + (size_t)cur.pn * tstep;
    S.a_ready(cur);
    if constexpr (SP2) {
        PG8_STAGE(PG8_SB(0, 0), cB, voffB); PG8_STAGE(PG8_SB(0, 1), cB + hstep, voffB); PG8_STAGE(PG8_SA(0, 0), cA, voffA); PG8_STAGE(PG8_SA(0, 1), cA + hstep, voffA);
        if (wr == 1) PG8_BAR;
        PG8_WAIT_V(2); PG8_BAR;
        PG8_STAGE(PG8_SB(1, 0), cB + kstep, voffB); PG8_STAGE(PG8_SA(1, 0), cA + kstep, voffA); PG8_STAGE(PG8_SB(1, 1), cB + hstep + kstep, voffB);
        PG8_WAIT_V(6); PG8_BAR;
    } else {
        PG8_STAGE(PG8_SB(0, 0), cB, voffB); PG8_STAGE(PG8_SA(0, 0), cA, voffA); PG8_STAGE(PG8_SB(0, 1), cB + hstep, voffB); PG8_STAGE(PG8_SA(0, 1), cA + hstep, voffA);
        if (wr == 1) PG8_BAR;
        PG8_WAIT_V(4); PG8_BAR;
        PG8_STAGE(PG8_SB(1, 0), cB + kstep, voffB); PG8_STAGE(PG8_SA(1, 0), cA + kstep, voffA); PG8_STAGE(PG8_SB(1, 1), cB + hstep + kstep, voffB);
        PG8_WAIT_V(6); PG8_BAR;
    }
    for (;;) {
        const bool has_next = S.next(ui + 1, nxt);
        const char* nA = has_next ? (const char*)g.A + (size_t)nxt.pm * tstep : cA; const char* nB = has_next ? (const char*)g.Bt + (size_t)nxt.pn * tstep : cB;
        for (int t = 0; t < nt; t += 2) {
            const bool last = (t == nt - 2);
            const char* a1 = cA + (size_t)(t + 1) * kstep;
            const char* a2 = last ? nA : cA + (size_t)(t + 2) * kstep; const char* b2 = last ? nB : cB + (size_t)(t + 2) * kstep;
            const char* a3 = a2 + kstep; const char* b3 = b2 + kstep;
            if (last && has_next) S.a_ready(nxt);
            if constexpr (SP2) {
            PG8_LDB(B0, 0, 0); PG8_LDB(B1, 0, 1); PG8_SCHED; PG8_LDA(At, 0, 0); PG8_STAGE(PG8_SA(1, 1), a1 + hstep, voffA);
            PG8_WAIT_V(8); PG8_WAIT_L(0); PG8_BAR; PG8_MMA(0, 0, At, B0); PG8_MMA(0, 1, At, B1); PG8_BAR; PG8_SCHED;
            PG8_LDA(At, 0, 1); PG8_STAGE(PG8_SB(0, 0), b2, voffB); PG8_STAGE(PG8_SB(0, 1), b2 + hstep, voffB); PG8_STAGE(PG8_SA(0, 0), a2, voffA);
            PG8_WAIT_V(8); PG8_WAIT_L(0); PG8_BAR; PG8_MMA(1, 0, At, B0); PG8_MMA(1, 1, At, B1); PG8_BAR; PG8_SCHED;
            PG8_LDB(B0, 1, 0); PG8_LDB(B1, 1, 1); PG8_SCHED; PG8_LDA(At, 1, 0); PG8_STAGE(PG8_SA(0, 1), a2 + hstep, voffA);
            PG8_WAIT_V(8); PG8_WAIT_L(0); PG8_BAR; PG8_MMA(0, 0, At, B0); PG8_MMA(0, 1, At, B1); PG8_BAR; PG8_SCHED;
            PG8_LDA(At, 1, 1); PG8_STAGE(PG8_SB(1, 0), b3, voffB); PG8_STAGE(PG8_SB(1, 1), b3 + hstep, voffB); PG8_STAGE(PG8_SA(1, 0), a3, voffA);
            PG8_WAIT_V(8); PG8_WAIT_L(0); PG8_BAR; PG8_MMA(1, 0, At, B0); PG8_MMA(1, 1, At, B1); PG8_BAR; PG8_SCHED;
            } else {
            PG8_LDB(B0, 0, 0); PG8_SCHED; PG8_LDA(At, 0, 0); PG8_STAGE(PG8_SA(1, 1), a1 + hstep, voffA);
            PG8_WAIT_L(8); PG8_BAR; PG8_WAIT_L(0); PG8_MMA(0, 0, At, B0); PG8_BAR; PG8_SCHED;
            PG8_LDB(B1, 0, 1); PG8_STAGE(PG8_SB(0, 0), b2, voffB);
            PG8_BAR; PG8_WAIT_L(0); PG8_MMA(0, 1, At, B1); PG8_BAR;
            PG8_LDA(At, 0, 1); PG8_STAGE(PG8_SA(0, 0), a2, voffA);
            PG8_BAR; PG8_WAIT_L(0); PG8_MMA(1, 0, At, B0); PG8_BAR; PG8_SCHED;
            PG8_STAGE(PG8_SB(0, 1), b2 + hstep, voffB);
            PG8_WAIT_V(6); PG8_BAR; PG8_MMA(1, 1, At, B1); PG8_BAR;
            PG8_LDB(B0, 1, 0); PG8_SCHED; PG8_LDA(At, 1, 0); PG8_STAGE(PG8_SA(0, 1), a2 + hstep, voffA);
            PG8_WAIT_L(8); PG8_BAR; PG8_WAIT_L(0); PG8_MMA(0, 0, At, B0); PG8_BAR; PG8_SCHED;
            PG8_LDB(B1, 1, 1); PG8_STAGE(PG8_SB(1, 0), b3, voffB);
            PG8_BAR; PG8_WAIT_L(0); PG8_MMA(0, 1, At, B1); PG8_BAR;
            PG8_LDA(At, 1, 1); PG8_STAGE(PG8_SA(1, 0), a3, voffA);
            PG8_BAR; PG8_WAIT_L(0); PG8_MMA(1, 0, At, B0); PG8_BAR; PG8_SCHED;
            PG8_STAGE(PG8_SB(1, 1), b3 + hstep, voffB);
            PG8_WAIT_V(6); PG8_BAR; PG8_MMA(1, 1, At, B1); PG8_BAR;
            }
        }
        if constexpr (ALIGN_EPI) { if (wr == 0) PG8_BAR; }
        if constexpr (!Epi::AFTER_DRAIN) { E(acc, cur, wr, wc, fr, fq); S.done(cur); }
        if (!has_next) break;
#pragma unroll
        for (int a = 0; a < 2; ++a)
#pragma unroll
            for (int b = 0; b < 2; ++b)
#pragma unroll
                for (int m = 0; m < 4; ++m)
#pragma unroll
                    for (int n = 0; n < 2; ++n) acc[a][b][m][n] = (f32x4){0.f, 0.f, 0.f, 0.f};
        cur = nxt; cA = nA; cB = nB; ++ui;
        if constexpr (ALIGN_EPI) { if (wr == 1) PG8_BAR; }
    }
    PG8_WAIT_V(0);
    if constexpr (!ALIGN_EPI) { if (wr == 0) PG8_BAR; }
    PG8_BAR;
    if constexpr (Epi::AFTER_DRAIN) { E.fused(acc, cur, wr, wc, fr, fq, lds, wid, lane); S.done(cur); }
#undef PG8_SA
#undef PG8_SB
#undef PG8_STAGE
#undef PG8_LDA
#undef PG8_LDB
#undef PG8_MMA
#undef PG8_WAIT_V
#undef PG8_WAIT_L
#undef PG8_BAR
#undef PG8_SCHED
}
}

constexpr int BATCH = 8, SEQ = 8192, DM = 1024, MROWS = BATCH * SEQ, NIN = 1792, FF = 4096;
constexpr int COL_K = 512, COL_V = 640, COL_U = 768, COL_VG = 1280;
constexpr float ALPHA = 1.18920711500272f;
constexpr float LN_EPS = 1e-5f, LOG2E = 1.4426950408889634f, QSCALE = 0.125f * LOG2E;
constexpr int NWAVES = 8, NTHREADS = NWAVES * 64;
constexpr int LDS_BYTES = 147456;
#ifndef MK_N_LAUNCHES
#define MK_N_LAUNCHES 1
#endif
constexpr int N_PHASES = 7;

constexpr size_t MiB = 1u << 20;
constexpr size_t WS_WIN = 2 * MiB, WS_WOUT = 6 * MiB, WS_WF1 = 8 * MiB, WS_WF2 = 16 * MiB, WS_WSP = 24 * MiB;
constexpr size_t WS_STAT1 = 26 * MiB;
constexpr size_t WS_CGP = 28 * MiB, WS_CBP = WS_CGP + 256 * 1024;
constexpr size_t WS_CG = 29 * MiB, WS_CB = WS_CG + 16 * 1024;
constexpr size_t WS_X1 = 32 * MiB;
constexpr size_t WS_XB = 160 * MiB;
constexpr size_t WS_PROJ = 288 * MiB;
constexpr size_t WS_MIX = 512 * MiB;
constexpr size_t WS_H = 512 * MiB;
constexpr size_t WS_END = 1024 * MiB;

typedef unsigned short bf16_t;
typedef short bf16x8 __attribute__((ext_vector_type(8)));
typedef short s16x4 __attribute__((ext_vector_type(4)));
typedef float f32x4 __attribute__((ext_vector_type(4)));
typedef float f32x16 __attribute__((ext_vector_type(16)));
typedef unsigned u32x4 __attribute__((ext_vector_type(4)));
typedef unsigned u32x2 __attribute__((ext_vector_type(2)));
#define LAS __attribute__((address_space(3)))
using pg8::cvtpk;
__device__ __forceinline__ float bflo(unsigned w) { return __uint_as_float(w << 16); }
__device__ __forceinline__ float bfhi(unsigned w) { return __uint_as_float(w & 0xffff0000u); }
__device__ __forceinline__ float wave_sum(float v) {
#pragma unroll
    for (int o = 1; o < 64; o <<= 1) v += __shfl_xor(v, o);
    return v;
}

__device__ __forceinline__ void p0_transpose_item(const float* W, int K, int N, bf16_t* WT, LAS float* scr, int item, int lane) {
    const int nblk = N / 32, kb = item / nblk, nb = item % nblk, k0 = 64 * kb, n0 = 32 * nb;
#pragma unroll 8
    for (int i = 0; i < 32; ++i) { const int kk = 2 * i + (lane >> 5); scr[kk * 33 + (lane & 31)] = W[(size_t)(k0 + kk) * N + n0 + (lane & 31)]; }
    asm volatile("s_waitcnt lgkmcnt(0)" ::: "memory");
    const int c = lane & 7;
#pragma unroll
    for (int j = 0; j < 4; ++j) { const int n = (lane >> 3) + 8 * j; const LAS float* s = scr + (8 * c) * 33 + n;
        u32x4 o; o.x = cvtpk(s[0 * 33], s[1 * 33]); o.y = cvtpk(s[2 * 33], s[3 * 33]); o.z = cvtpk(s[4 * 33], s[5 * 33]); o.w = cvtpk(s[6 * 33], s[7 * 33]);
        *(u32x4*)(WT + (size_t)(n0 + n) * K + k0 + 8 * c) = o; }
    asm volatile("s_waitcnt lgkmcnt(0)" ::: "memory");
}
__device__ __forceinline__ void p0_transpose_ff1(const float* W, const float* g, const float* b, bf16_t* WT, float* cgp, float* cbp, LAS float* scr, int item, int lane) {
    constexpr int K = DM, N = FF;
    const int nblk = N / 32, kb = item / nblk, nb = item % nblk, k0 = 64 * kb, n0 = 32 * nb;
#pragma unroll 8
    for (int i = 0; i < 32; ++i) { const int kk = 2 * i + (lane >> 5); scr[kk * 33 + (lane & 31)] = W[(size_t)(k0 + kk) * N + n0 + (lane & 31)]; }
    asm volatile("s_waitcnt lgkmcnt(0)" ::: "memory");
    { const int n = lane & 31, hf = lane >> 5; float sg = 0.f, sb = 0.f;
#pragma unroll 8
      for (int kk = 0; kk < 32; ++kk) { const int k = hf * 32 + kk; const float w = scr[k * 33 + n]; sg += g[k0 + k] * w; sb += b[k0 + k] * w; }
      sg += __shfl_xor(sg, 32); sb += __shfl_xor(sb, 32);
      if (hf == 0) { cgp[(size_t)kb * N + n0 + n] = sg; cbp[(size_t)kb * N + n0 + n] = sb; } }
    const int c = lane & 7;
    const f32x4 ga = *(const f32x4*)(g + k0 + 8 * c), gb = *(const f32x4*)(g + k0 + 8 * c + 4);
#pragma unroll
    for (int j = 0; j < 4; ++j) { const int n = (lane >> 3) + 8 * j; const LAS float* s = scr + (8 * c) * 33 + n;
        u32x4 o; o.x = cvtpk(s[0 * 33] * ga.x, s[1 * 33] * ga.y); o.y = cvtpk(s[2 * 33] * ga.z, s[3 * 33] * ga.w); o.z = cvtpk(s[4 * 33] * gb.x, s[5 * 33] * gb.y); o.w = cvtpk(s[6 * 33] * gb.z, s[7 * 33] * gb.w);
        *(u32x4*)(WT + (size_t)(n0 + n) * K + k0 + 8 * c) = o; }
    asm volatile("s_waitcnt lgkmcnt(0)" ::: "memory");
}
__device__ __forceinline__ void row_to_bf16(const float* xrow, bf16_t* orow, int lane) {
    const f32x4* xr = (const f32x4*)xrow + lane; u32x2* o8 = (u32x2*)orow + lane;
    f32x4 v[4];
#pragma unroll
    for (int j = 0; j < 4; ++j) v[j] = xr[64 * j];
#pragma unroll
    for (int j = 0; j < 4; ++j) { u32x2 w; w.x = cvtpk(v[j].x, v[j].y); w.y = cvtpk(v[j].z, v[j].w); o8[64 * j] = w; }
}
__device__ __forceinline__ void ln_row(const float* xrow, const f32x4 (&g)[4], const f32x4 (&b)[4], bf16_t* oh, float* of, int lane) {
    const f32x4* xr = (const f32x4*)xrow + lane;
    f32x4 v[4]; float s = 0.f;
#pragma unroll
    for (int j = 0; j < 4; ++j) { v[j] = xr[64 * j]; s += (v[j].x + v[j].y) + (v[j].z + v[j].w); }
    const float mean = wave_sum(s) * (1.f / DM); float s2 = 0.f;
#pragma unroll
    for (int j = 0; j < 4; ++j) { v[j] = v[j] - mean; s2 += (v[j].x * v[j].x + v[j].y * v[j].y) + (v[j].z * v[j].z + v[j].w * v[j].w); }
    const float rstd = 1.f / sqrtf(wave_sum(s2) * (1.f / DM) + LN_EPS);
#pragma unroll
    for (int j = 0; j < 4; ++j) { const f32x4 o = v[j] * rstd * g[j] + b[j];
        if (oh) { u32x2 w; w.x = cvtpk(o.x, o.y); w.y = cvtpk(o.z, o.w); ((u32x2*)oh + lane)[64 * j] = w; }
        else ((f32x4*)of + lane)[64 * j] = o; }
}

namespace mix {
constexpr int KS = 144, VS = 192;
constexpr int OFF_K = 0, OFF_V = 384 * KS;
constexpr int VNS = 1088;
constexpr int OFF_SSQA = 128 * VNS;
constexpr int OFF_SSQ8 = OFF_SSQA + 1024;
static_assert(OFF_V + 384 * VS <= OFF_SSQA && OFF_SSQ8 + 4096 <= LDS_BYTES, "P2 LDS map");

__device__ __forceinline__ bf16x8 tr_frag(const LAS unsigned char* p0, const LAS unsigned char* p1) {
    const s16x4 lo = __builtin_bit_cast(s16x4, __builtin_amdgcn_ds_read_tr16_b64_v4i16((LAS s16x4*)p0));
    const s16x4 hi = __builtin_bit_cast(s16x4, __builtin_amdgcn_ds_read_tr16_b64_v4i16((LAS s16x4*)p1));
    return (bf16x8){lo[0], lo[1], lo[2], lo[3], hi[0], hi[1], hi[2], hi[3]};
}
#define MFMA32(a, b, c) __builtin_amdgcn_mfma_f32_32x32x16_bf16((a), (b), (c), 0, 0, 0)

__device__ __forceinline__ void kv_fetch(u32x4 (&pk)[6], u32x4 (&pv)[6], const bf16_t* __restrict__ proj, int b, int n, int g, int tid) {
#pragma unroll
    for (int i = 0; i < 6; ++i) { const int c = tid + NTHREADS * i, j = c >> 3, ch = c & 7, kpos = n * 128 - 128 + j;
        pk[i] = (u32x4){0u, 0u, 0u, 0u}; pv[i] = (u32x4){0u, 0u, 0u, 0u};
        if (kpos >= 0 && kpos < SEQ) { const bf16_t* src = proj + ((size_t)b * SEQ + kpos) * NIN + COL_K + g * 64 + ch * 8; pk[i] = *(const u32x4*)src; pv[i] = *(const u32x4*)(src + (COL_V - COL_K)); } }
}
__device__ __forceinline__ void kv_commit(LAS unsigned char* lds, const u32x4 (&pk)[6], const u32x4 (&pv)[6], int tid) {
#pragma unroll
    for (int i = 0; i < 6; ++i) { const int c = tid + NTHREADS * i, j = c >> 3, ch = c & 7;
        *(LAS u32x4*)(lds + OFF_K + j * KS + ch * 16) = pk[i]; *(LAS u32x4*)(lds + OFF_V + j * VS + ch * 16) = pv[i]; }
}
__device__ __forceinline__ void attn_unit(LAS unsigned char* lds, const bf16_t* __restrict__ proj, bf16_t* __restrict__ mixed, const float* __restrict__ sink, const float* __restrict__ ga, int b, int n) {
    int tid = threadIdx.x; asm volatile("" : "+v"(tid));
    const int lane = tid & 63, r32 = lane & 31, h = lane >> 5, wid = __builtin_amdgcn_readfirstlane(tid >> 6), qs = wid & 3, hp = wid >> 2;
    const size_t row0 = (size_t)b * SEQ + (size_t)n * 128;
    const int qrel = 32 * qs + r32;
    const bf16_t* qrow = proj + (row0 + qrel) * NIN;
    const int grp = lane >> 4, i16 = lane & 15, qq = i16 >> 2, pp = i16 & 3;
    const int vlane = (4 * h + qq) * VS + (16 * (grp & 1) + 4 * pp) * 2;
    const int klane = r32 * KS + h * 16;
    unsigned held[4][16]; float ssq = 0.f;
    u32x4 pk[6], pv[6];
    kv_fetch(pk, pv, proj, b, n, 0, tid);
    const int kt_lo = (n == 0) ? ((4 - qs) > 0 ? 4 - qs : 0) : 0;
    const int kt_hi = (n == SEQ / 128 - 1) ? ((8 - qs) < 9 ? 8 - qs : 9) : 9;
#pragma unroll
    for (int g = 0; g < 2; ++g) {
        bf16x8 qr[4];
#pragma unroll
        for (int d0 = 0; d0 < 4; ++d0) qr[d0] = *(const bf16x8*)(qrow + (4 * g + 2 * hp) * 64 + d0 * 16 + h * 8);
        __syncthreads();
        kv_commit(lds, pk, pv, tid);
        if (g == 0) kv_fetch(pk, pv, proj, b, n, 1, tid);
        __syncthreads();
#pragma unroll
        for (int hh = 0; hh < 2; ++hh) {
            const int head = 4 * g + 2 * hp + hh;
            if (hh == 1) {
#pragma unroll
                for (int d0 = 0; d0 < 4; ++d0) qr[d0] = *(const bf16x8*)(qrow + head * 64 + d0 * 16 + h * 8); }
            float m = sink[head] * LOG2E, l = (h == 0) ? 1.f : 0.f;
            f32x16 o0 = {}, o1 = {};
            const float slope2 = __builtin_amdgcn_exp2f(-(float)(head + 1)) * LOG2E;
            for (int kt = kt_lo; kt < kt_hi; ++kt) {
                const int j0 = 32 * (qs + kt);
                f32x16 p = {};
                const LAS unsigned char* kp = lds + OFF_K + j0 * KS + klane;
#pragma unroll
                for (int d0 = 0; d0 < 4; ++d0) { const bf16x8 kf = *(const LAS bf16x8*)(kp + d0 * 32); p = MFMA32(kf, qr[d0], p); }
                const float fb = (float)(qrel - (j0 + 4 * h - 128));
                float tm = -1e30f;
                if (kt == 0 || kt == 8) {
#pragma unroll
                    for (int r = 0; r < 16; ++r) { const float t = fb - (float)((r & 3) + 8 * (r >> 2)); float s = __builtin_fmaf(-slope2, __builtin_fabsf(t), p[r]);
                        s = (__builtin_fabsf(t) <= 128.f) ? s : -1e30f; p[r] = s; tm = fmaxf(tm, s); }
                } else {
#pragma unroll
                    for (int r = 0; r < 16; ++r) { const float t = fb - (float)((r & 3) + 8 * (r >> 2)); const float s = __builtin_fmaf(-slope2, __builtin_fabsf(t), p[r]); p[r] = s; tm = fmaxf(tm, s); }
                }
                tm = fmaxf(tm, __shfl_xor(tm, 32));
                if (__builtin_amdgcn_ballot_w64(tm > m)) {
                    const float mn = fmaxf(m, tm), f = __builtin_amdgcn_exp2f(m - mn); m = mn; l *= f;
#pragma unroll
                    for (int r = 0; r < 16; ++r) { o0[r] *= f; o1[r] *= f; }
                }
                float ls = 0.f;
#pragma unroll
                for (int r = 0; r < 16; ++r) { p[r] = __builtin_amdgcn_exp2f(p[r] - m); ls += p[r]; }
                l += ls;
                u32x4 w0, w1;
                w0.x = cvtpk(p[0], p[1]); w0.y = cvtpk(p[2], p[3]); w0.z = cvtpk(p[4], p[5]); w0.w = cvtpk(p[6], p[7]);
                w1.x = cvtpk(p[8], p[9]); w1.y = cvtpk(p[10], p[11]); w1.z = cvtpk(p[12], p[13]); w1.w = cvtpk(p[14], p[15]);
                const bf16x8 pb0 = __builtin_bit_cast(bf16x8, w0), pb1 = __builtin_bit_cast(bf16x8, w1);
                const LAS unsigned char* vp = lds + OFF_V + j0 * VS + vlane;
                o0 = MFMA32(tr_frag(vp, vp + 8 * VS), pb0, o0);
                o1 = MFMA32(tr_frag(vp + 64, vp + 8 * VS + 64), pb0, o1);
                o0 = MFMA32(tr_frag(vp + 16 * VS, vp + 24 * VS), pb1, o0);
                o1 = MFMA32(tr_frag(vp + 16 * VS + 64, vp + 24 * VS + 64), pb1, o1);
            }
            l += __shfl_xor(l, 32);
            const float inv = 1.f / l;
#pragma unroll
            for (int r = 0; r < 16; ++r) { o0[r] *= inv; o1[r] *= inv; ssq += o0[r] * o0[r] + o1[r] * o1[r]; }
#pragma unroll
            for (int r = 0; r < 8; ++r) { held[g * 2 + hh][r] = cvtpk(o0[2 * r], o0[2 * r + 1]); held[g * 2 + hh][8 + r] = cvtpk(o1[2 * r], o1[2 * r + 1]); }
        }
    }
    ssq += __shfl_xor(ssq, 32);
    LAS float* ssqA = (LAS float*)(lds + OFF_SSQA);
    if (h == 0) ssqA[hp * 128 + qrel] = ssq;
    __syncthreads();
    const float tot = ssqA[qrel] + ssqA[128 + qrel]; const float rstd = 1.f / sqrtf(tot * (1.f / 512.f) + LN_EPS);
    bf16_t* orow = mixed + (row0 + qrel) * DM;
#pragma unroll
    for (int x = 0; x < 4; ++x) { const int head = 4 * (x >> 1) + 2 * hp + (x & 1);
#pragma unroll
        for (int db = 0; db < 2; ++db)
#pragma unroll
            for (int rq = 0; rq < 4; ++rq) { const int d = head * 64 + 32 * db + 8 * rq + 4 * h; const f32x4 g4 = *(const f32x4*)(ga + d);
                const unsigned wa = held[x][db * 8 + 2 * rq], wb = held[x][db * 8 + 2 * rq + 1];
                u32x2 w; w.x = cvtpk(bflo(wa) * rstd * g4.x, bfhi(wa) * rstd * g4.y); w.y = cvtpk(bflo(wb) * rstd * g4.z, bfhi(wb) * rstd * g4.w);
                *(u32x2*)(orow + d) = w; } }
}

__device__ __forceinline__ void swap32(unsigned& a, unsigned& b) { auto rr = __builtin_amdgcn_permlane32_swap(a, b, false, false); a = rr[0]; b = rr[1]; }
__device__ __forceinline__ void sgu_compute(LAS unsigned char* lds, const bf16_t* __restrict__ proj, bf16_t* __restrict__ mixed, const bf16_t* __restrict__ wsf, const float* __restrict__ bsp, const float* __restrict__ gn, size_t row0) {
    int tid = threadIdx.x; asm volatile("" : "+v"(tid));
    const int lane = tid & 63, r32 = lane & 31, h = lane >> 5, g = __builtin_amdgcn_readfirstlane(tid >> 6);
    const int grp = lane >> 4, i16 = lane & 15, qq = i16 >> 2, pp = i16 & 3;
    const int vnlane = (8 * h + qq) * VNS + (64 * g + 16 * (grp & 1) + 4 * pp) * 2;
    LAS float* ssq8 = (LAS float*)(lds + OFF_SSQ8);
    unsigned hv[4][16];
    bf16x8 wf[8];
    const bf16_t* wbase = wsf + (size_t)g * 4 * 8 * 512 + lane * 8;
#pragma unroll
    for (int ks = 0; ks < 8; ++ks) wf[ks] = *(const bf16x8*)(wbase + ks * 512);
#pragma unroll
    for (int tb = 0; tb < 4; ++tb) {
        const int t = 32 * tb + r32;
        const bf16_t* gurow = proj + (row0 + t) * NIN + COL_U + 64 * g + 8 * h;
        u32x4 gl[4];
#pragma unroll
        for (int e = 0; e < 4; ++e) gl[e] = *(const u32x4*)(gurow + 16 * e);
        const float bs = bsp[g * 128 + t];
        bf16x8 wn[8];
        if (tb < 3) {
#pragma unroll
            for (int ks = 0; ks < 8; ++ks) wn[ks] = *(const bf16x8*)(wbase + ((tb + 1) * 8 + ks) * 512); }
        f32x16 a0 = {}, a1 = {};
#pragma unroll
        for (int ks = 0; ks < 8; ++ks) { const LAS unsigned char* vp = lds + ks * 16 * VNS + vnlane;
            a0 = MFMA32(tr_frag(vp, vp + 4 * VNS), wf[ks], a0); a1 = MFMA32(tr_frag(vp + 64, vp + 4 * VNS + 64), wf[ks], a1); }
        float ss = 0.f;
#pragma unroll
        for (int e = 0; e < 4; ++e) {
            unsigned x0 = gl[e].x, x1 = gl[e].y, y0 = gl[e].z, y1 = gl[e].w;
            swap32(x0, y0); swap32(x1, y1);
            const f32x16& a = (e >> 1) ? a1 : a0; const int rq = 2 * (e & 1);
            const float v0 = bflo(x0) * (a[4 * rq + 0] + bs), v1 = bfhi(x0) * (a[4 * rq + 1] + bs), v2 = bflo(x1) * (a[4 * rq + 2] + bs), v3 = bfhi(x1) * (a[4 * rq + 3] + bs);
            const float v4 = bflo(y0) * (a[4 * rq + 4] + bs), v5 = bfhi(y0) * (a[4 * rq + 5] + bs), v6 = bflo(y1) * (a[4 * rq + 6] + bs), v7 = bfhi(y1) * (a[4 * rq + 7] + bs);
            ss += ((v0 * v0 + v1 * v1) + (v2 * v2 + v3 * v3)) + ((v4 * v4 + v5 * v5) + (v6 * v6 + v7 * v7));
            hv[tb][4 * e + 0] = cvtpk(v0, v1); hv[tb][4 * e + 1] = cvtpk(v2, v3); hv[tb][4 * e + 2] = cvtpk(v4, v5); hv[tb][4 * e + 3] = cvtpk(v6, v7); }
        ss += __shfl_xor(ss, 32); if (h == 0) ssq8[g * 128 + t] = ss;
        if (tb < 3) {
#pragma unroll
            for (int ks = 0; ks < 8; ++ks) wf[ks] = wn[ks]; }
    }
    __syncthreads();
#pragma unroll
    for (int tb = 0; tb < 4; ++tb) {
        const int t = 32 * tb + r32;
        float tot = 0.f;
#pragma unroll
        for (int gg = 0; gg < 8; ++gg) tot += ssq8[gg * 128 + t];
        const float rstd = 1.f / sqrtf(tot * (1.f / 512.f) + LN_EPS);
        bf16_t* orow = mixed + (row0 + t) * DM + 512 + 64 * g + 8 * h;
#pragma unroll
        for (int e = 0; e < 4; ++e) { const int db = e >> 1, rq = 2 * (e & 1);
            const f32x4 ge = *(const f32x4*)(gn + 64 * g + 32 * db + 8 * rq + 4 * h), go = *(const f32x4*)(gn + 64 * g + 32 * db + 8 * rq + 8 + 4 * h);
            const unsigned w0 = hv[tb][4 * e + 0], w1 = hv[tb][4 * e + 1], w2 = hv[tb][4 * e + 2], w3 = hv[tb][4 * e + 3];
            unsigned x0 = cvtpk(bflo(w0) * rstd * ge.x, bfhi(w0) * rstd * ge.y), x1 = cvtpk(bflo(w1) * rstd * ge.z, bfhi(w1) * rstd * ge.w);
            unsigned y0 = cvtpk(bflo(w2) * rstd * go.x, bfhi(w2) * rstd * go.y), y1 = cvtpk(bflo(w3) * rstd * go.z, bfhi(w3) * rstd * go.w);
            swap32(x0, y0); swap32(x1, y1);
            *(u32x4*)(orow + 16 * e) = (u32x4){x0, x1, y0, y1}; }
    }
}
__device__ __forceinline__ void sgu_unit(LAS unsigned char* lds, const bf16_t* __restrict__ proj, bf16_t* __restrict__ mixed, const float* __restrict__ lng, const float* __restrict__ lnb,
                                         const bf16_t* __restrict__ wsb, const float* __restrict__ bsp, const float* __restrict__ gn, int b, int n) {
    int tid = threadIdx.x; asm volatile("" : "+v"(tid));
    const int lane = tid & 63, wid = __builtin_amdgcn_readfirstlane(tid >> 6);
    const size_t row0 = (size_t)b * SEQ + (size_t)n * 128;
    const f32x4 ga = *(const f32x4*)(lng + lane * 8), gb = *(const f32x4*)(lng + lane * 8 + 4), ba = *(const f32x4*)(lnb + lane * 8), bb = *(const f32x4*)(lnb + lane * 8 + 4);
    u32x4 vw[8];
#pragma unroll
    for (int i = 0; i < 8; ++i) vw[i] = *(const u32x4*)(proj + (row0 + wid * 16 + i) * NIN + COL_VG + lane * 8);
    __syncthreads();
#pragma unroll
    for (int hb = 0; hb < 2; ++hb) {
        u32x4 vc[8];
#pragma unroll
        for (int i = 0; i < 8; ++i) vc[i] = vw[i];
        if (hb == 0) {
#pragma unroll
            for (int i = 0; i < 8; ++i) vw[i] = *(const u32x4*)(proj + (row0 + wid * 16 + 8 + i) * NIN + COL_VG + lane * 8); }
#pragma unroll
        for (int i = 0; i < 8; ++i) { const int t = wid * 16 + hb * 8 + i; const u32x4 w = vc[i];
            float v[8] = {bflo(w.x), bfhi(w.x), bflo(w.y), bfhi(w.y), bflo(w.z), bfhi(w.z), bflo(w.w), bfhi(w.w)};
            float s = 0.f;
#pragma unroll
            for (int k = 0; k < 8; ++k) s += v[k];
            const float mean = wave_sum(s) * (1.f / 512.f); float s2 = 0.f;
#pragma unroll
            for (int k = 0; k < 8; ++k) { v[k] -= mean; s2 += v[k] * v[k]; }
            const float rstd = 1.f / sqrtf(wave_sum(s2) * (1.f / 512.f) + LN_EPS);
            u32x4 o; o.x = cvtpk(v[0] * rstd * ga.x + ba.x, v[1] * rstd * ga.y + ba.y); o.y = cvtpk(v[2] * rstd * ga.z + ba.z, v[3] * rstd * ga.w + ba.w);
            o.z = cvtpk(v[4] * rstd * gb.x + bb.x, v[5] * rstd * gb.y + bb.y); o.w = cvtpk(v[6] * rstd * gb.z + bb.z, v[7] * rstd * gb.w + bb.w);
            *(LAS u32x4*)(lds + t * VNS + lane * 16) = o; }
    }
    __syncthreads();
    sgu_compute(lds, proj, mixed, wsb, bsp, gn, row0);
}
}

struct Args { const float* in[16]; float* out; unsigned char* ws; int ph_lo, ph_hi; };
__global__ void __launch_bounds__(NTHREADS, 2) fwd_kernel(Args args) {
    extern __shared__ __attribute__((aligned(16))) unsigned char lds_raw[];
    LAS unsigned char* lds = (LAS unsigned char*)lds_raw;
    cg::grid_group grid = cg::this_grid();
    int tid = threadIdx.x; asm volatile("" : "+v"(tid));
    const int lane = tid & 63, wave = __builtin_amdgcn_readfirstlane(tid >> 6);
    const int G = gridDim.x, bx = blockIdx.x;
    const int vcu = (G % 8 == 0) ? (bx % 8) * (G / 8) + bx / 8 : bx;
    const int gw = vcu * NWAVES + wave, NGW = G * NWAVES;
    unsigned char* ws = args.ws;
    const float* x = args.in[0]; const float* w_in = args.in[1]; const float* sink = args.in[2]; const float* lng = args.in[3]; const float* lnb = args.in[4];
    const float* w_sp = args.in[5]; const float* b_sp = args.in[6]; const float* ga = args.in[7]; const float* gn = args.in[8]; const float* w_out = args.in[9];
    const float* ln1g = args.in[10]; const float* ln1b = args.in[11]; const float* w_f1 = args.in[12]; const float* w_f2 = args.in[13]; const float* ln2g = args.in[14]; const float* ln2b = args.in[15];
    bf16_t* WIN = (bf16_t*)(ws + WS_WIN); bf16_t* WOUT = (bf16_t*)(ws + WS_WOUT); bf16_t* WF1 = (bf16_t*)(ws + WS_WF1); bf16_t* WF2 = (bf16_t*)(ws + WS_WF2); bf16_t* WSP = (bf16_t*)(ws + WS_WSP);
    bf16_t* X1 = (bf16_t*)(ws + WS_X1); bf16_t* XB = (bf16_t*)(ws + WS_XB); bf16_t* PROJ = (bf16_t*)(ws + WS_PROJ); bf16_t* MIX = (bf16_t*)(ws + WS_MIX); bf16_t* HB = (bf16_t*)(ws + WS_H);
    float* out = args.out;
    float* STAT1 = (float*)(ws + WS_STAT1); float* CGP = (float*)(ws + WS_CGP); float* CBP = (float*)(ws + WS_CBP); float* CG = (float*)(ws + WS_CG); float* CB = (float*)(ws + WS_CB);
    const int lo = args.ph_lo, hi = args.ph_hi;
#define IN(k) (lo <= (k) && (k) < hi)
#define SEAM(k) do { if (IN(k) && IN((k) + 1)) grid.sync(); } while (0)
#ifndef PROBE_PHASE
#define PROBE_PHASE -1
#endif
#define REPS(k) for (int rep_ = 0; rep_ < ((k) == PROBE_PHASE ? 2 : 1); ++rep_, ((k) == PROBE_PHASE && rep_ == 1 ? grid.sync() : (void)0))

    REPS(0) if (IN(0)) {
        LAS float* scr = (LAS float*)(lds + wave * 16384);
        constexpr int I_IN = (DM / 64) * (NIN / 32), I_OUT = (DM / 64) * (DM / 32), I_F1 = (DM / 64) * (FF / 32), I_F2 = (FF / 64) * (DM / 32), I_SP = 8 * 128 * 128 / 512;
        constexpr int NITEMS = I_IN + I_OUT + I_F1 + I_F2 + I_SP;
        for (int it = gw; it < NITEMS; it += NGW) {
            int r = it;
            if (r < I_IN) { p0_transpose_item(w_in, DM, NIN, WIN, scr, r, lane); continue; } r -= I_IN;
            if (r < I_OUT) { p0_transpose_item(w_out, DM, DM, WOUT, scr, r, lane); continue; } r -= I_OUT;
            if (r < I_F1) { p0_transpose_ff1(w_f1, ln1g, ln1b, WF1, CGP, CBP, scr, r, lane); continue; } r -= I_F1;
            if (r < I_F2) { p0_transpose_item(w_f2, FF, DM, WF2, scr, r, lane); continue; } r -= I_F2;
            { const int sg = r >> 5, stb = (r >> 3) & 3, sks = r & 7;
              const float* src = w_sp + ((size_t)(sg * 128 + 32 * stb + (lane & 31))) * 128 + 16 * sks + 8 * (lane >> 5); const f32x4 a = *(const f32x4*)src, b = *(const f32x4*)(src + 4);
              u32x4 o; o.x = cvtpk(a.x, a.y); o.y = cvtpk(a.z, a.w); o.z = cvtpk(b.x, b.y); o.w = cvtpk(b.z, b.w); *(u32x4*)(WSP + (size_t)r * 512 + lane * 8) = o; }
        }
        for (int m = gw; m < MROWS; m += NGW) row_to_bf16(x + (size_t)m * DM, XB + (size_t)m * DM, lane);
    }
    SEAM(0);
    REPS(1) if (IN(1)) {
        for (int n = gw * 64 + lane; n < 2 * FF; n += NGW * 64) { const int which = n / FF, nn = n % FF; const float* src = which ? CBP : CGP; float acc = 0.f;
#pragma unroll
            for (int kb = 0; kb < 16; ++kb) acc += src[(size_t)kb * FF + nn];
            (which ? CB : CG)[nn] = acc; }
        pg8::Gemm g{XB, WIN, MROWS, NIN, DM}; pg8::StaticOrder S; S.init(MROWS, NIN, G, bx);
        pg8::EpiAct E{PROJ, NIN, 0, QSCALE};
        pg8::gemm_phase<pg8::EpiAct, pg8::StaticOrder, true, true>(lds, g, S, E);
    }
    SEAM(1);
    REPS(2) if (IN(2)) {
        constexpr int NU = BATCH * (SEQ / 128);
        const int per = (NU + G - 1) / G;
        for (int i = 0; i < per; ++i) { const int u = vcu * per + i; if (u >= NU) break;
            const int b = u / (SEQ / 128), n = u % (SEQ / 128);
#ifndef PROBE_P2
#define PROBE_P2 0
#endif
            for (int rp = 0; rp < (PROBE_P2 == 1 ? 2 : 1); ++rp) mix::attn_unit(lds, PROJ, MIX, sink, ga, b, n);
            for (int rp = 0; rp < (PROBE_P2 == 2 ? 2 : 1); ++rp) mix::sgu_unit(lds, PROJ, MIX, lng, lnb, WSP, b_sp, gn, b, n); }
    }
    SEAM(2);
    REPS(3) if (IN(3)) {
        pg8::Gemm g{MIX, WOUT, MROWS, DM, DM}; pg8::StaticOrder S; S.init(MROWS, DM, G, bx);
        pg8::EpiLnStat E{x, X1, STAT1, DM, ALPHA, lds + 131072};
        pg8::gemm_phase<pg8::EpiLnStat, pg8::StaticOrder, true, true>(lds, g, S, E);
    }
    SEAM(3);
    REPS(4) if (IN(4)) {
        pg8::Gemm g{X1, WF1, MROWS, FF, DM}; pg8::StaticOrder S; S.init(MROWS, FF, G, bx);
        pg8::EpiFfUp E{HB, FF, STAT1, CG, CB, LN_EPS};
        pg8::gemm_phase<pg8::EpiFfUp, pg8::StaticOrder, true, true>(lds, g, S, E);
    }
    SEAM(4);
    REPS(5) if (IN(5)) {
        pg8::Gemm g{HB, WF2, MROWS, DM, FF}; pg8::StaticOrder S; S.init(MROWS, DM, G, bx);
        pg8::EpiFfDown E{X1, STAT1, ln1g, ln1b, out, DM, ALPHA, LN_EPS};
        pg8::gemm_phase<pg8::EpiFfDown, pg8::StaticOrder, true, true>(lds, g, S, E);
    }
    SEAM(5);
    REPS(6) if (IN(6)) {
        f32x4 g4[4], b4[4];
#pragma unroll
        for (int j = 0; j < 4; ++j) { g4[j] = ((const f32x4*)ln2g + lane)[64 * j]; b4[j] = ((const f32x4*)ln2b + lane)[64 * j]; }
        for (int m = gw; m < MROWS; m += NGW) ln_row(out + (size_t)m * DM, g4, b4, nullptr, out + (size_t)m * DM, lane);
    }
#undef IN
#undef SEAM
}

extern "C" void kernel_launch(void* const* d_in, const int* in_sizes, int n_in, void* d_out, int out_size, void* d_ws, size_t ws_size, hipStream_t stream) {
    static int grid = 0;
    if (grid == 0) {
        if (n_in != 16 || in_sizes[0] != MROWS * DM || out_size != MROWS * DM || ws_size < WS_END) {
            fprintf(stderr, "kernel_launch: unexpected shapes (n_in %d, in0 %d, out %d, ws %zu); nothing launched\n", n_in, n_in > 0 ? in_sizes[0] : -1, out_size, ws_size); grid = -1; return; }
        int dev = 0, cus = 0, per_cu = 0;
        if (hipGetDevice(&dev) != hipSuccess || hipDeviceGetAttribute(&cus, hipDeviceAttributeMultiprocessorCount, dev) != hipSuccess) { grid = -1; return; }
        if (hipFuncSetAttribute((const void*)fwd_kernel, hipFuncAttributeMaxDynamicSharedMemorySize, LDS_BYTES) != hipSuccess) { fprintf(stderr, "kernel_launch: hipFuncSetAttribute failed\n"); grid = -1; return; }
        if (hipOccupancyMaxActiveBlocksPerMultiprocessor(&per_cu, (const void*)fwd_kernel, NTHREADS, LDS_BYTES) != hipSuccess || per_cu < 1) { fprintf(stderr, "kernel_launch: occupancy query says %d blocks per CU\n", per_cu); per_cu = 1; }
        (void)hipGetLastError();
        grid = cus * per_cu;
    }
    if (grid < 0) return;
    Args a{};
    for (int i = 0; i < 16; ++i) a.in[i] = (const float*)d_in[i];
    a.out = (float*)d_out; a.ws = (unsigned char*)d_ws;
    if (MK_N_LAUNCHES == 1) {
        a.ph_lo = 0; a.ph_hi = N_PHASES;
        void* kargs[] = {&a};
        const hipError_t e = hipLaunchCooperativeKernel((const void*)fwd_kernel, dim3(grid), dim3(NTHREADS), kargs, LDS_BYTES, stream);
        if (e != hipSuccess) fprintf(stderr, "kernel_launch: cooperative launch failed: %s (grid %d)\n", hipGetErrorString(e), grid);
    } else {
        for (int k = 0; k < N_PHASES; ++k) { a.ph_lo = k; a.ph_hi = k + 1;
            hipLaunchKernelGGL(fwd_kernel, dim3(grid), dim3(NTHREADS), LDS_BYTES, stream, a); }
    }
}
```
